# Optimizing an MI355X kernel written in HIP

```python
import jax, jax.numpy as jnp
from jax import lax
import numpy as np

D_MODEL = 1024
BATCH = 2
SEQ = 8192
DEPTH = 2

D_PLE = 256
N_MIXERS = 4
GROUP_WIDTH = D_MODEL // N_MIXERS
MIX_WIDTH = N_MIXERS * GROUP_WIDTH
HEAD_DIM = GROUP_WIDTH // 4
EPS = 1e-6
A_HEADS = GROUP_WIDTH // HEAD_DIM
A_KV_HEADS = 2
WINDOW = 128
ROPE_THETA = 10000.0
B_HEADS = GROUP_WIDTH // HEAD_DIM
B_CONV = 4
DN_CHUNK = 64
C_CHUNK = 128
C_GROUPS = 4
D_CONV = 31
D_GROUPS = 4
A_Q = A_HEADS * HEAD_DIM
A_KV = A_KV_HEADS * HEAD_DIM
B_QKV = 3 * GROUP_WIDTH
C_UV = 2 * GROUP_WIDTH
D_GLU = 2 * GROUP_WIDTH
COL_SIZES = (A_Q, A_KV, A_KV, B_QKV, B_HEADS, B_HEADS, C_UV, D_GLU, MIX_WIDTH)
IN_WIDTH = A_Q + 2 * A_KV + B_QKV + 2 * B_HEADS + C_UV + D_GLU + MIX_WIDTH

kernel_name = "hybrid_parallel_group_trunk"


def rms_norm(x, gain):
    xf = x.astype(jnp.float32)
    y = xf * lax.rsqrt(jnp.mean(xf * xf, -1, keepdims=True) + EPS)
    return (y * gain.astype(jnp.float32)).astype(x.dtype)


def group_layer_norm(x, gain, bias, groups):
    lead, c = x.shape[:-1], x.shape[-1]
    xf = x.astype(jnp.float32).reshape(*lead, groups, c // groups)
    mu = jnp.mean(xf, -1, keepdims=True)
    var = jnp.mean(jnp.square(xf - mu), -1, keepdims=True)
    y = ((xf - mu) * lax.rsqrt(var + EPS)).reshape(*lead, c)
    return (y * gain.astype(jnp.float32) + bias.astype(jnp.float32)).astype(x.dtype)


def l2_norm(x):
    return x * lax.rsqrt(jnp.sum(x * x, -1, keepdims=True) + EPS)


def causal_depthwise_conv(x, w):
    k, c = w.shape
    return lax.conv_general_dilated(x, w[:, None, :].astype(x.dtype), window_strides=(1,),
                                    padding=[(k - 1, 0)], dimension_numbers=('NWC', 'WIO', 'NWC'),
                                    feature_group_count=c)


def rope_tables(seq, dim):
    inv = ROPE_THETA ** (-jnp.arange(0, dim, 2, dtype=jnp.float32) / dim)
    ang = jnp.arange(seq, dtype=jnp.float32)[:, None] * inv[None, :]
    return jnp.cos(ang), jnp.sin(ang)


def apply_rope(x, cos, sin):
    x1, x2 = jnp.split(x.astype(jnp.float32), 2, -1)
    c, s = cos[None, :, None, :], sin[None, :, None, :]
    return jnp.concatenate([x1 * c - x2 * s, x2 * c + x1 * s], -1).astype(x.dtype)


def split_columns(z, sizes):
    out, start = [], 0
    for n in sizes:
        out.append(z[..., start:start + n])
        start += n
    return out


def sliding_window_attention(q, k, v, q_gain, k_gain, sink):
    b, s, _ = q.shape
    g = A_HEADS // A_KV_HEADS
    nb = s // WINDOW
    cos, sin = rope_tables(s, HEAD_DIM)
    q = apply_rope(rms_norm(q.reshape(b, s, A_HEADS, HEAD_DIM), q_gain), cos, sin)
    k = apply_rope(rms_norm(k.reshape(b, s, A_KV_HEADS, HEAD_DIM), k_gain), cos, sin)
    v = v.reshape(b, s, A_KV_HEADS, HEAD_DIM)
    qb = q.reshape(b, nb, WINDOW, A_KV_HEADS, g, HEAD_DIM)
    kb = k.reshape(b, nb, WINDOW, A_KV_HEADS, HEAD_DIM)
    vb = v.reshape(b, nb, WINDOW, A_KV_HEADS, HEAD_DIM)
    zk = jnp.zeros_like(kb[:, :1])
    k2 = jnp.concatenate([jnp.concatenate([zk, kb[:, :-1]], 1), kb], 2)
    v2 = jnp.concatenate([jnp.concatenate([zk, vb[:, :-1]], 1), vb], 2)
    sc = jnp.einsum('bnqhgd,bnkhd->bnhgqk', qb, k2,
                    preferred_element_type=jnp.float32) * (HEAD_DIM ** -0.5)
    qi = jnp.arange(WINDOW)[:, None]
    kj = jnp.arange(2 * WINDOW)[None, :]
    rel = qi + WINDOW - kj
    band = (rel >= 0) & (rel < WINDOW)
    blk = jnp.arange(nb)[:, None, None]
    mask = band[None] & ((blk > 0) | (kj >= WINDOW)[None])
    sc = jnp.where(mask[None, :, None, None], sc, -jnp.inf)
    sk = sink.astype(jnp.float32).reshape(A_KV_HEADS, g)[None, None, :, :, None, None]
    m = jnp.maximum(jnp.max(sc, -1, keepdims=True), sk)
    e = jnp.exp(sc - m)
    probs = e / (jnp.sum(e, -1, keepdims=True) + jnp.exp(sk - m))
    o = jnp.einsum('bnhgqk,bnkhd->bnqhgd', probs.astype(v.dtype), v2)
    return o.reshape(b, s, A_Q)


def gated_deltanet(qkv, beta_logit, a_logit, conv_w, a_log, dt_bias, out_gain):
    b, s, _ = qkv.shape
    h, d, c = B_HEADS, HEAD_DIM, DN_CHUNK
    nc = s // c
    f32 = jnp.float32
    qkv = jax.nn.silu(causal_depthwise_conv(qkv, conv_w)).astype(f32)
    q, k, v = jnp.split(qkv, 3, -1)

    def heads(t):
        return t.reshape(b, nc, c, h, d).transpose(0, 3, 1, 2, 4)

    def per_head(t):
        return t.reshape(b, nc, c, h).transpose(0, 3, 1, 2)

    q = l2_norm(heads(q)) * (d ** -0.5)
    k = l2_norm(heads(k))
    v = heads(v)
    beta = per_head(jax.nn.sigmoid(beta_logit.astype(f32)))
    gdec = -jnp.exp(a_log.astype(f32)) * jax.nn.softplus(a_logit.astype(f32) + dt_bias.astype(f32))
    gc = jnp.cumsum(per_head(gdec), -1)
    ci = jnp.arange(c)
    tril = ci[:, None] >= ci[None, :]
    strict = ci[:, None] > ci[None, :]
    decay = jnp.exp(jnp.where(tril, gc[..., :, None] - gc[..., None, :], -jnp.inf))
    kb = k * beta[..., None]
    amat = jnp.where(strict, jnp.einsum('bhncd,bhnsd->bhncs', kb, k) * decay, 0.0)
    rhs = jnp.concatenate([v * beta[..., None], kb * jnp.exp(gc)[..., None]], -1)
    sol = lax.linalg.triangular_solve(amat + jnp.eye(c, dtype=f32), rhs, left_side=True, lower=True)
    u, w = jnp.split(sol, 2, -1)
    qk = jnp.einsum('bhncd,bhnsd->bhncs', q, k) * decay
    qg = q * jnp.exp(gc)[..., None]
    kg = k * jnp.exp(gc[..., -1:] - gc)[..., None]
    cdec = jnp.exp(gc[..., -1])

    def step(state, xs):
        u_c, w_c, qg_c, qk_c, kg_c, dec_c = xs
        v_new = u_c - jnp.einsum('bhcd,bhde->bhce', w_c, state)
        o_c = jnp.einsum('bhcd,bhde->bhce', qg_c, state) + jnp.einsum('bhcs,bhse->bhce', qk_c, v_new)
        state = state * dec_c[..., None, None] + jnp.einsum('bhcd,bhce->bhde', kg_c, v_new)
        return state, o_c

    xs = (jnp.moveaxis(u, 2, 0), jnp.moveaxis(w, 2, 0), jnp.moveaxis(qg, 2, 0),
          jnp.moveaxis(qk, 2, 0), jnp.moveaxis(kg, 2, 0), jnp.moveaxis(cdec, 2, 0))
    _, o = lax.scan(step, jnp.zeros((b, h, d, d), f32), xs)
    o = o.transpose(1, 0, 3, 2, 4).reshape(b, s, h, d)
    return rms_norm(o, out_gain).reshape(b, s, h * d)


def chunked_spatial_gating(uv, ln_gain, ln_bias, w_s, b_s):
    b, s, _ = uv.shape
    nc = s // C_CHUNK
    u, v = jnp.split(jax.nn.gelu(uv), 2, -1)
    v = group_layer_norm(v, ln_gain, ln_bias, 1)
    width = v.shape[-1]
    v = v.reshape(b, nc, C_CHUNK, C_GROUPS, width // C_GROUPS)
    ci = jnp.arange(C_CHUNK)
    w = jnp.where((ci[:, None] >= ci[None, :])[None], w_s, 0.0).astype(v.dtype)
    z = jnp.einsum('gij,bnjgc->bnigc', w, v) + b_s.T.astype(v.dtype)[None, None, :, :, None]
    return u * z.reshape(b, s, width)


def conformer_conv(glu_in, conv_w, conv_b, ln_gain, ln_bias):
    a, g = jnp.split(glu_in, 2, -1)
    y = a * jax.nn.sigmoid(g)
    y = causal_depthwise_conv(y, conv_w) + conv_b.astype(y.dtype)
    y = group_layer_norm(y, ln_gain, ln_bias, D_GROUPS)
    return jax.nn.silu(y)


def setup_inputs(seed: int = 0) -> dict:
    key = jax.random.key(seed)
    ks = jax.random.split(key, 24)
    f32 = jnp.float32
    nrm = lambda k, shape, scale: jax.random.normal(k, shape, f32) * scale
    dt = jnp.exp(jax.random.uniform(ks[10], (DEPTH, B_HEADS), f32, np.log(1e-3), np.log(1e-1)))
    return {
        "x": nrm(ks[0], (BATCH, SEQ, D_MODEL), 1.0),
        "p": nrm(ks[1], (DEPTH, BATCH, SEQ, D_PLE), 1.0),
        "norm_gain": 1.0 + nrm(ks[2], (DEPTH, D_MODEL), 0.02),
        "w_in": nrm(ks[3], (DEPTH, D_MODEL, IN_WIDTH), D_MODEL ** -0.5),
        "w_out": nrm(ks[4], (DEPTH, MIX_WIDTH, D_MODEL), MIX_WIDTH ** -0.5),
        "a_q_gain": 1.0 + nrm(ks[5], (DEPTH, HEAD_DIM), 0.02),
        "a_k_gain": 1.0 + nrm(ks[6], (DEPTH, HEAD_DIM), 0.02),
        "a_sink": nrm(ks[7], (DEPTH, A_HEADS), 1.0),
        "b_conv": nrm(ks[8], (DEPTH, B_CONV, B_QKV), B_CONV ** -0.5),
        "b_a_log": jnp.log(jax.random.uniform(ks[9], (DEPTH, B_HEADS), f32, 1.0, 16.0)),
        "b_dt_bias": dt + jnp.log(-jnp.expm1(-dt)),
        "b_out_gain": 1.0 + nrm(ks[11], (DEPTH, HEAD_DIM), 0.02),
        "c_ln_gain": 1.0 + nrm(ks[12], (DEPTH, GROUP_WIDTH), 0.02),
        "c_ln_bias": nrm(ks[13], (DEPTH, GROUP_WIDTH), 0.02),
        "c_w_s": nrm(ks[14], (DEPTH, C_GROUPS, C_CHUNK, C_CHUNK), C_CHUNK ** -0.5),
        "c_b_s": 1.0 + nrm(ks[15], (DEPTH, C_GROUPS, C_CHUNK), 0.02),
        "d_conv": nrm(ks[16], (DEPTH, D_CONV, GROUP_WIDTH), D_CONV ** -0.5),
        "d_conv_bias": nrm(ks[17], (DEPTH, GROUP_WIDTH), 0.02),
        "d_ln_gain": 1.0 + nrm(ks[18], (DEPTH, GROUP_WIDTH), 0.02),
        "d_ln_bias": nrm(ks[19], (DEPTH, GROUP_WIDTH), 0.02),
        "ple_w": nrm(ks[20], (DEPTH, D_PLE, D_MODEL), D_PLE ** -0.5),
        "ple_gate_norm": 1.0 + nrm(ks[21], (DEPTH, D_MODEL), 0.02),
        "ple_gate_w": nrm(ks[22], (DEPTH, D_MODEL, D_MODEL), D_MODEL ** -0.5),
    }


def reference(x, p, norm_gain, w_in, w_out, a_q_gain, a_k_gain, a_sink, b_conv, b_a_log, b_dt_bias,
              b_out_gain, c_ln_gain, c_ln_bias, c_w_s, c_b_s, d_conv, d_conv_bias, d_ln_gain, d_ln_bias,
              ple_w, ple_gate_norm, ple_gate_w):
    for i in range(DEPTH):
        h = rms_norm(x, norm_gain[i])
        z = h @ w_in[i]
        a_q, a_k, a_v, b_qkv, b_beta, b_alpha, c_uv, d_glu, gate = split_columns(z, COL_SIZES)
        o_a = sliding_window_attention(a_q, a_k, a_v, a_q_gain[i], a_k_gain[i], a_sink[i])
        o_b = gated_deltanet(b_qkv, b_beta, b_alpha, b_conv[i], b_a_log[i], b_dt_bias[i],
                             b_out_gain[i]).astype(h.dtype)
        o_c = chunked_spatial_gating(c_uv, c_ln_gain[i], c_ln_bias[i], c_w_s[i], c_b_s[i])
        o_d = conformer_conv(d_glu, d_conv[i], d_conv_bias[i], d_ln_gain[i], d_ln_bias[i])
        mix = jnp.concatenate([o_a, o_b, o_c, o_d], -1) * jax.nn.silu(gate)
        x = x + mix @ w_out[i]
        ple_gate = jax.nn.sigmoid(rms_norm(x, ple_gate_norm[i]) @ ple_gate_w[i])
        x = x + ple_gate * (p[i] @ ple_w[i])
    return x
```

```cpp
#include <hip/hip_runtime.h>
#include <hip/hip_cooperative_groups.h>
#include <cstdio>
#include <cstdint>
namespace cg = cooperative_groups;
#define PROBE_REP_G1 1
#define PROBE_REP_PREP 1
#define PROBE_REP_M2 1
#define PROBE_EXTRA_SYNC 0
#define PROBE_REP_P0 1
#define PROBE_REP_FIN 1
#define PROBE_REP_G23 1
#define CG_SEAM_MASK 0x000u
#define BARRIER_KIND 2
#define PROBE_M2_MODE 0
#define PROBE_MIX_MASK 7

__device__ __forceinline__ unsigned char* opaque_ptr(unsigned char* p) { asm volatile("" : "+s"(p)); return p; }
__device__ __forceinline__ int opaque_tid() { int t = threadIdx.x; asm volatile("" : "+v"(t)); return t; }
namespace pg8 {
#define PG8_LAS __attribute__((address_space(3)))
typedef unsigned short bf16_t;
typedef short bf16x8 __attribute__((ext_vector_type(8)));
typedef float f32x4 __attribute__((ext_vector_type(4)));
typedef unsigned u32x4 __attribute__((ext_vector_type(4)));
typedef unsigned u32x2 __attribute__((ext_vector_type(2)));
constexpr int BM = 256, BK = 64, HALF = 128, HTB = HALF * BK * 2, STAGE_BYTES = 8 * HTB, NXCD = 8, WGM = 8;

__host__ __device__ __forceinline__ int lds_byte(int r, int c) { const int st = (r >> 4) * 2 + (c >> 5), rr = r & 15, cc = c & 31, ob = rr * 64 + cc * 2; return st * 1024 + (ob ^ (((ob >> 9) & 1) << 5)); }
__host__ __device__ __forceinline__ void stage_rc(int b, int& R, int& C) { const int st = b / 1024, sb = b % 1024, swz = sb ^ (((sb >> 9) & 1) << 5); R = (st >> 1) * 16 + swz / 64; C = (st & 1) * 32 + (swz % 64) / 2; }
__host__ __device__ __forceinline__ int perm32(int rho) { const int n = rho >> 4, i = rho & 15; return 8 * (i >> 2) + 4 * n + (i & 3); }

struct Unit { int pm, pn; };
struct Gemm { const bf16_t* A; const bf16_t* Bt; int M, N, K; };

struct StaticOrder {
    int nM, nN, nwg, G, c;
    __host__ __device__ void init(int M, int N, int G_, int c_) { nM = M / BM; nN = N / BM; nwg = nM * nN; G = G_; c = c_; }
    __host__ __device__ bool next(int i, Unit& u) const {
        const long L = (long)i * G + c; if (L >= nwg) return false;
        int wgid = (int)L; { const int q = nwg / NXCD, r = nwg % NXCD, xcd = wgid % NXCD, off = wgid / NXCD; wgid = (xcd < r ? xcd * (q + 1) : r * (q + 1) + (xcd - r) * q) + off; }
        const int nig = WGM * nN, gid = wgid / nig, fm = gid * WGM, gsz = (nM - fm) < WGM ? (nM - fm) : WGM;
        u.pm = fm + ((wgid % nig) % gsz); u.pn = (wgid % nig) / gsz; return true;
    }
    __device__ __forceinline__ void a_ready(const Unit&) const {}
    __device__ __forceinline__ void done(const Unit&) const {}
};
struct PPOrder {
    int c, G;
    __device__ bool next(int i, Unit& u) const {
        int L;
        if (G == 256) { if (c < 128 || i >= 2) return false; L = (c - 128) * 2 + i; }
        else { L = i * G + c; if (L >= 256) return false; }
        u.pm = L >> 2; u.pn = L & 3; return true;
    }
    __device__ __forceinline__ void a_ready(const Unit&) const {}
    __device__ __forceinline__ void done(const Unit&) const {}
};

__device__ __forceinline__ unsigned cvt_pk_bf16(float lo, float hi) { unsigned r; asm volatile("v_cvt_pk_bf16_f32 %0, %1, %2" : "=v"(r) : "v"(lo), "v"(hi)); return r; }

template <class Epi, class Sched, bool ALIGN_EPI = false, bool SP2 = false>
__device__ __forceinline__ void gemm_phase(PG8_LAS unsigned char* lds, const Gemm g, const Sched& S, const Epi& E) {
    const int tid = opaque_tid(), wid = __builtin_amdgcn_readfirstlane(tid >> 6), lane = tid & 63, wr = wid >> 2, wc = wid & 3, fr = lane & 15, fq = lane >> 4;
    const int K = g.K, nt = K / BK;
    unsigned voffA[2], voffB[2];
#pragma unroll
    for (int i = 0; i < 2; ++i) { int R, C; stage_rc(tid * 16 + i * 8192, R, C); const int Rb = Epi::PERM ? ((R & ~31) + perm32(R & 31)) : R;
        voffA[i] = (unsigned)(R * K + C) * 2u; voffB[i] = (unsigned)(Rb * K + C) * 2u; }
    const size_t kstep = (size_t)(BK * 2);
    const size_t hstep = (size_t)HALF * K * 2;
    const size_t tstep = 2 * hstep;
    const unsigned ldsw = (unsigned)wid * 1024u;
    const int aoff = lds_byte(wr * 64 + fr, fq * 8), boff = lds_byte(wc * 32 + fr, fq * 8);
#define PG8_SA(b, h) (((b) * 2 + (h)) * HTB)
#define PG8_SB(b, h) ((4 + (b) * 2 + (h)) * HTB)
#define PG8_STAGE(bufoff, gbase, voff) do { _Pragma("unroll") for (int _i = 0; _i < 2; ++_i) \
        __builtin_amdgcn_global_load_lds((const unsigned*)((const char*)(gbase) + (voff)[_i]), (PG8_LAS unsigned*)(lds + (bufoff) + ldsw + _i * 8192), 16, 0, 0); } while (0)
#define PG8_LDA(dst, b, h) do { _Pragma("unroll") for (int m = 0; m < 4; ++m) _Pragma("unroll") for (int k = 0; k < 2; ++k) dst[m][k] = *(const PG8_LAS bf16x8*)(lds + PG8_SA(b, h) + aoff + m * 2048 + k * 1024); } while (0)
#define PG8_LDB(dst, b, h) do { _Pragma("unroll") for (int n = 0; n < 2; ++n) _Pragma("unroll") for (int k = 0; k < 2; ++k) dst[n][k] = *(const PG8_LAS bf16x8*)(lds + PG8_SB(b, h) + boff + n * 2048 + k * 1024); } while (0)
#define PG8_MMA(ai, bj, At, Bt) do { __builtin_amdgcn_s_setprio(1); _Pragma("unroll") for (int m = 0; m < 4; ++m) _Pragma("unroll") for (int n = 0; n < 2; ++n) _Pragma("unroll") for (int k = 0; k < 2; ++k) \
        acc[ai][bj][m][n] = __builtin_amdgcn_mfma_f32_16x16x32_bf16(Bt[n][k], At[m][k], acc[ai][bj][m][n], 0, 0, 0); __builtin_amdgcn_s_setprio(0); } while (0)
#define PG8_WAIT_V(n) asm volatile("s_waitcnt vmcnt(" #n ")" ::: "memory")
#define PG8_WAIT_L(n) asm volatile("s_waitcnt lgkmcnt(" #n ")" ::: "memory")
#define PG8_BAR __builtin_amdgcn_s_barrier()
#define PG8_SCHED __builtin_amdgcn_sched_barrier(0)
    Unit cur, nxt; int ui = 0;
    if (!S.next(0, cur)) return;
    f32x4 acc[2][2][4][2];
#pragma unroll
    for (int a = 0; a < 2; ++a)
#pragma unroll
        for (int b = 0; b < 2; ++b)
#pragma unroll
            for (int m = 0; m < 4; ++m)
#pragma unroll
                for (int n = 0; n < 2; ++n) acc[a][b][m][n] = (f32x4){0.f, 0.f, 0.f, 0.f};
    bf16x8 At[4][2], B0[2][2], B1[2][2];
    const char* cA = (const char*)g.A + (size_t)cur.pm * tstep; const char* cB = (const char*)g.Bt + (size_t)cur.pn * tstep;
    S.a_ready(cur);
    if constexpr (SP2) {
        PG8_STAGE(PG8_SB(0, 0), cB, voffB); PG8_STAGE(PG8_SB(0, 1), cB + hstep, voffB); PG8_STAGE(PG8_SA(0, 0), cA, voffA); PG8_STAGE(PG8_SA(0, 1), cA + hstep, voffA);
        if (wr == 1) PG8_BAR;
        PG8_WAIT_V(2); PG8_BAR;
        PG8_STAGE(PG8_SB(1, 0), cB + kstep, voffB); PG8_STAGE(PG8_SA(1, 0), cA + kstep, voffA); PG8_STAGE(PG8_SB(1, 1), cB + hstep + kstep, voffB);
        PG8_WAIT_V(6); PG8_BAR;
    } else {
        PG8_STAGE(PG8_SB(0, 0), cB, voffB); PG8_STAGE(PG8_SA(0, 0), cA, voffA); PG8_STAGE(PG8_SB(0, 1), cB + hstep, voffB); PG8_STAGE(PG8_SA(0, 1), cA + hstep, voffA);
        if (wr == 1) PG8_BAR;
        PG8_WAIT_V(4); PG8_BAR;
        PG8_STAGE(PG8_SB(1, 0), cB + kstep, voffB); PG8_STAGE(PG8_SA(1, 0), cA + kstep, voffA); PG8_STAGE(PG8_SB(1, 1), cB + hstep + kstep, voffB);
        PG8_WAIT_V(6); PG8_BAR;
    }
    for (;;) {
        const bool has_next = S.next(ui + 1, nxt);
        const char* nA = has_next ? (const char*)g.A + (size_t)nxt.pm * tstep : cA; const char* nB = has_next ? (const char*)g.Bt + (size_t)nxt.pn * tstep : cB;
#pragma unroll 1
        for (int t = 0; t < nt; t += 2) {
            const bool last = (t == nt - 2);
            const char* a1 = cA + (size_t)(t + 1) * kstep;
            const char* a2 = last ? nA : cA + (size_t)(t + 2) * kstep; const char* b2 = last ? nB : cB + (size_t)(t + 2) * kstep;
            const char* a3 = a2 + kstep; const char* b3 = b2 + kstep;
            if (last && has_next) S.a_ready(nxt);
            if constexpr (SP2) {
            PG8_LDB(B0, 0, 0); PG8_LDB(B1, 0, 1); PG8_SCHED; PG8_LDA(At, 0, 0); PG8_STAGE(PG8_SA(1, 1), a1 + hstep, voffA);
            PG8_WAIT_V(8); PG8_WAIT_L(0); PG8_BAR; PG8_MMA(0, 0, At, B0); PG8_MMA(0, 1, At, B1); PG8_BAR; PG8_SCHED;
            PG8_LDA(At, 0, 1); PG8_STAGE(PG8_SB(0, 0), b2, voffB); PG8_STAGE(PG8_SB(0, 1), b2 + hstep, voffB); PG8_STAGE(PG8_SA(0, 0), a2, voffA);
            PG8_WAIT_V(8); PG8_WAIT_L(0); PG8_BAR; PG8_MMA(1, 0, At, B0); PG8_MMA(1, 1, At, B1); PG8_BAR; PG8_SCHED;
            PG8_LDB(B0, 1, 0); PG8_LDB(B1, 1, 1); PG8_SCHED; PG8_LDA(At, 1, 0); PG8_STAGE(PG8_SA(0, 1), a2 + hstep, voffA);
            PG8_WAIT_V(8); PG8_WAIT_L(0); PG8_BAR; PG8_MMA(0, 0, At, B0); PG8_MMA(0, 1, At, B1); PG8_BAR; PG8_SCHED;
            PG8_LDA(At, 1, 1); PG8_STAGE(PG8_SB(1, 0), b3, voffB); PG8_STAGE(PG8_SB(1, 1), b3 + hstep, voffB); PG8_STAGE(PG8_SA(1, 0), a3, voffA);
            PG8_WAIT_V(8); PG8_WAIT_L(0); PG8_BAR; PG8_MMA(1, 0, At, B0); PG8_MMA(1, 1, At, B1); PG8_BAR; PG8_SCHED;
            } else {
            PG8_LDB(B0, 0, 0); PG8_SCHED; PG8_LDA(At, 0, 0); PG8_STAGE(PG8_SA(1, 1), a1 + hstep, voffA);
            PG8_WAIT_L(8); PG8_BAR; PG8_WAIT_L(0); PG8_MMA(0, 0, At, B0); PG8_BAR; PG8_SCHED;
            PG8_LDB(B1, 0, 1); PG8_STAGE(PG8_SB(0, 0), b2, voffB);
            PG8_BAR; PG8_WAIT_L(0); PG8_MMA(0, 1, At, B1); PG8_BAR;
            PG8_LDA(At, 0, 1); PG8_STAGE(PG8_SA(0, 0), a2, voffA);
            PG8_BAR; PG8_WAIT_L(0); PG8_MMA(1, 0, At, B0); PG8_BAR; PG8_SCHED;
            PG8_STAGE(PG8_SB(0, 1), b2 + hstep, voffB);
            PG8_WAIT_V(6); PG8_BAR; PG8_MMA(1, 1, At, B1); PG8_BAR;
            PG8_LDB(B0, 1, 0); PG8_SCHED; PG8_LDA(At, 1, 0); PG8_STAGE(PG8_SA(0, 1), a2 + hstep, voffA);
            PG8_WAIT_L(8); PG8_BAR; PG8_WAIT_L(0); PG8_MMA(0, 0, At, B0); PG8_BAR; PG8_SCHED;
            PG8_LDB(B1, 1, 1); PG8_STAGE(PG8_SB(1, 0), b3, voffB);
            PG8_BAR; PG8_WAIT_L(0); PG8_MMA(0, 1, At, B1); PG8_BAR;
            PG8_LDA(At, 1, 1); PG8_STAGE(PG8_SA(1, 0), a3, voffA);
            PG8_BAR; PG8_WAIT_L(0); PG8_MMA(1, 0, At, B0); PG8_BAR; PG8_SCHED;
            PG8_STAGE(PG8_SB(1, 1), b3 + hstep, voffB);
            PG8_WAIT_V(6); PG8_BAR; PG8_MMA(1, 1, At, B1); PG8_BAR;
            }
        }
        if constexpr (ALIGN_EPI) { if (wr == 0) PG8_BAR; }
        E(acc, cur, wr, wc, fr, fq); S.done(cur);
        if (!has_next) break;
#pragma unroll
        for (int a = 0; a < 2; ++a)
#pragma unroll
            for (int b = 0; b < 2; ++b)
#pragma unroll
                for (int m = 0; m < 4; ++m)
#pragma unroll
                    for (int n = 0; n < 2; ++n) acc[a][b][m][n] = (f32x4){0.f, 0.f, 0.f, 0.f};
        cur = nxt; cA = nA; cB = nB; ++ui;
        if constexpr (ALIGN_EPI) { if (wr == 1) PG8_BAR; }
    }
    PG8_WAIT_V(0);
    if constexpr (!ALIGN_EPI) { if (wr == 0) PG8_BAR; }
    PG8_BAR;
#undef PG8_SA
#undef PG8_SB
#undef PG8_STAGE
#undef PG8_LDA
#undef PG8_LDB
#undef PG8_MMA
#undef PG8_WAIT_V
#undef PG8_WAIT_L
#undef PG8_BAR
#undef PG8_SCHED
}
}

#define LAS __attribute__((address_space(3)))
typedef unsigned short bf16;
typedef unsigned v4u __attribute__((ext_vector_type(4)));
typedef unsigned v2u __attribute__((ext_vector_type(2)));
typedef float f32x4 __attribute__((ext_vector_type(4)));
typedef short bf16x8 __attribute__((ext_vector_type(8)));
typedef LAS unsigned char* lds_t;

constexpr int M = 16384, SEQ = 8192, DM = 1024, ZP = 3584, NIN = 3336;
constexpr float EPS = 1e-6f;
constexpr int ZC_GATE = 2304;
constexpr size_t MiB = 1u << 20;
constexpr size_t WS_CTL = 0, CTL_BYTES = 1 * MiB;
constexpr size_t WS_WIN = 1 * MiB;
constexpr size_t WS_WOUT = 15 * MiB;
constexpr size_t WS_WG = 19 * MiB;
constexpr size_t WS_WPLE = 23 * MiB;
constexpr size_t WS_CWS = 24 * MiB;
constexpr size_t WS_ROPE = 25 * MiB;
constexpr size_t WS_BA = 27 * MiB;
constexpr size_t WS_CDEC = 27 * MiB + 512 * 1024;
constexpr size_t WS_XB = 28 * MiB;
constexpr size_t WS_Z = 60 * MiB;
constexpr size_t WS_X1 = 60 * MiB, WS_X1B = 124 * MiB;
constexpr size_t WS_PP = 172 * MiB;
constexpr size_t WS_DN = 204 * MiB;
constexpr size_t WS_SSP = 252 * MiB;
constexpr size_t WS_END = 255 * MiB;
constexpr int CW_CTR = 0;
constexpr int CW_BAR = 131072;
constexpr int CW_SS0 = 1024, CW_SS1 = 1024 + 16384, CW_SS2 = 1024 + 3 * 16384;
constexpr int LDS_BYTES = 157696, MISC_OFF = 157440;
constexpr int DN_ITEM = 49152;

struct Args { const float* in[23]; float* out; unsigned char* ws; int ph_lo, ph_hi; };

typedef float f32x2_t __attribute__((ext_vector_type(2))); typedef __bf16 bf16x2_t __attribute__((ext_vector_type(2)));
__device__ __forceinline__ unsigned pk2(float lo, float hi) { f32x2_t v = {lo, hi}; bf16x2_t b = __builtin_convertvector(v, bf16x2_t); return __builtin_bit_cast(unsigned, b); }
__device__ __forceinline__ unsigned f2bf(float f) { return pk2(f, 0.f) & 0xffffu; }
__device__ __forceinline__ float bflo(unsigned w) { return __uint_as_float(w << 16); }
__device__ __forceinline__ float bfhi(unsigned w) { return __uint_as_float(w & 0xffff0000u); }
__device__ __forceinline__ float sigmoidf_(float x) { return __builtin_amdgcn_rcpf(1.f + __expf(-x)); }
__device__ __forceinline__ float siluf_(float x) { return x * __builtin_amdgcn_rcpf(1.f + __expf(-x)); }
__device__ __forceinline__ float geluf_(float x) { const float u = 0.7978845608028654f * (x + 0.044715f * x * x * x); return x * __builtin_amdgcn_rcpf(1.f + __expf(-2.f * u)); }
__device__ __forceinline__ float quad_sum(float v) {
    v += __int_as_float(__builtin_amdgcn_update_dpp(0, __float_as_int(v), 0xB1, 0xF, 0xF, true));
    v += __int_as_float(__builtin_amdgcn_update_dpp(0, __float_as_int(v), 0x4E, 0xF, 0xF, true));
    return v;
}
__device__ __forceinline__ float wave_sum_dpp(float v) {
    v += __int_as_float(__builtin_amdgcn_update_dpp(0, __float_as_int(v), 0xB1, 0xF, 0xF, true));
    v += __int_as_float(__builtin_amdgcn_update_dpp(0, __float_as_int(v), 0x4E, 0xF, 0xF, true));
    v += __int_as_float(__builtin_amdgcn_update_dpp(0, __float_as_int(v), 0x141, 0xF, 0xF, true));
    v += __int_as_float(__builtin_amdgcn_update_dpp(0, __float_as_int(v), 0x140, 0xF, 0xF, true));
    const int iv = __float_as_int(v);
    return (__int_as_float(__builtin_amdgcn_readlane(iv, 0)) + __int_as_float(__builtin_amdgcn_readlane(iv, 16))) +
           (__int_as_float(__builtin_amdgcn_readlane(iv, 32)) + __int_as_float(__builtin_amdgcn_readlane(iv, 48)));
}
__device__ __forceinline__ float wave_sum(float v) {
#pragma unroll
    for (int o = 1; o < 64; o <<= 1) v += __shfl_xor(v, o);
    return v;
}
__device__ __forceinline__ bf16x8 pack8(f32x4 lo, f32x4 hi) {
    v4u w; w.x = pk2(lo[0], lo[1]); w.y = pk2(lo[2], lo[3]); w.z = pk2(hi[0], hi[1]); w.w = pk2(hi[2], hi[3]);
    return __builtin_bit_cast(bf16x8, w);
}
#define UNPACK8(VV, dst, o) do { (dst)[(o) + 0] = bflo((VV)[0]); (dst)[(o) + 1] = bfhi((VV)[0]); (dst)[(o) + 2] = bflo((VV)[1]); (dst)[(o) + 3] = bfhi((VV)[1]); \
    (dst)[(o) + 4] = bflo((VV)[2]); (dst)[(o) + 5] = bfhi((VV)[2]); (dst)[(o) + 6] = bflo((VV)[3]); (dst)[(o) + 7] = bfhi((VV)[3]); } while (0)
#define LDS_WAIT() asm volatile("s_waitcnt lgkmcnt(0)" ::: "memory")
__device__ __forceinline__ int frag_off_perm(int m, int k) {
    return ((((m >> 4) * 2 + (k >> 5)) * 64 + (((k >> 2) & 3) * 16 + (m & 15))) * 8) + ((k >> 4) & 1) * 4 + (k & 3);
}
__device__ __forceinline__ int u_off(int i, int e) { return (e >> 4) * 1024 + (i >> 4) * 256 + (((i >> 2) & 3) * 16 + (e & 15)) * 4 + (i & 3); }

__device__ __forceinline__ float sum16(const float* p) {
    const f32x4 a = *(const f32x4*)p, b = *(const f32x4*)(p + 4), c = *(const f32x4*)(p + 8), d = *(const f32x4*)(p + 12);
    return ((a[0] + a[1]) + (a[2] + a[3])) + ((b[0] + b[1]) + (b[2] + b[3])) + ((c[0] + c[1]) + (c[2] + c[3])) + ((d[0] + d[1]) + (d[2] + d[3]));
}
struct EpiZ {
    static constexpr bool PERM = true;
    bf16* Z; const float* ss; float* BA; int parts;
    __device__ __forceinline__ void operator()(const f32x4 (&acc)[2][2][4][2], const pg8::Unit& u, int wr, int wc, int fr, int fq) const {
        const int row0 = u.pm * 256 + wr * 64 + fr, col0 = u.pn * 256 + wc * 32 + 8 * fq;
        const bool ba = (u.pn == 13) && (wc == 0) && (fq == 0);
#pragma unroll
        for (int ai = 0; ai < 2; ++ai)
#pragma unroll
            for (int m = 0; m < 4; ++m) {
                const int row = row0 + ai * 128 + m * 16;
                const float rs = rsqrtf((parts == 1 ? ss[row] : sum16(ss + (size_t)row * 16)) * (1.f / 1024.f) + EPS);
                bf16* rowp = Z + (size_t)row * ZP + col0;
#pragma unroll
                for (int bj = 0; bj < 2; ++bj) {
                    const f32x4 v0 = acc[ai][bj][m][0] * rs, v1 = acc[ai][bj][m][1] * rs;
                    v4u w; w.x = pg8::cvt_pk_bf16(v0[0], v0[1]); w.y = pg8::cvt_pk_bf16(v0[2], v0[3]); w.z = pg8::cvt_pk_bf16(v1[0], v1[1]); w.w = pg8::cvt_pk_bf16(v1[2], v1[3]);
                    if (u.pn != 13) *(v4u*)(rowp + bj * 128) = w;
                    if (bj == 0 && ba) { *(f32x4*)(BA + (size_t)row * 8) = v0; *(f32x4*)(BA + (size_t)row * 8 + 4) = v1; }
                }
            }
    }
};
struct EpiPlain {
    static constexpr bool PERM = true;
    bf16* O; int ldc;
    __device__ __forceinline__ void operator()(const f32x4 (&acc)[2][2][4][2], const pg8::Unit& u, int wr, int wc, int fr, int fq) const {
        const int row0 = u.pm * 256 + wr * 64 + fr, col0 = u.pn * 256 + wc * 32 + 8 * fq;
#pragma unroll
        for (int ai = 0; ai < 2; ++ai)
#pragma unroll
            for (int m = 0; m < 4; ++m) {
                bf16* rowp = O + (size_t)(row0 + ai * 128 + m * 16) * ldc + col0;
#pragma unroll
                for (int bj = 0; bj < 2; ++bj) {
                    const f32x4 v0 = acc[ai][bj][m][0], v1 = acc[ai][bj][m][1];
                    v4u w; w.x = pg8::cvt_pk_bf16(v0[0], v0[1]); w.y = pg8::cvt_pk_bf16(v0[2], v0[3]); w.z = pg8::cvt_pk_bf16(v1[0], v1[1]); w.w = pg8::cvt_pk_bf16(v1[2], v1[3]);
                    *(v4u*)(rowp + bj * 128) = w;
                }
            }
    }
};
struct EpiRes {
    static constexpr bool PERM = true;
    const float* xin; bf16* x1b; float* ss;
    __device__ __forceinline__ void operator()(const f32x4 (&acc)[2][2][4][2], const pg8::Unit& u, int wr, int wc, int fr, int fq) const {
        const int col0 = u.pn * 256 + wc * 32 + 8 * fq;
#pragma unroll
        for (int aim = 0; aim < 4; ++aim) {
            const int ai = aim >> 1, m0 = (aim & 1) * 2;
            f32x4 r[4][2][2];
#pragma unroll
            for (int m = m0; m < m0 + 2; ++m)
#pragma unroll
                for (int bj = 0; bj < 2; ++bj)
#pragma unroll
                    for (int n = 0; n < 2; ++n) r[m][bj][n] = *(const f32x4*)(xin + (size_t)(u.pm * 256 + ai * 128 + wr * 64 + m * 16 + fr) * DM + col0 + bj * 128 + 4 * n);
#pragma unroll
            for (int m = m0; m < m0 + 2; ++m) {
                const int row = u.pm * 256 + ai * 128 + wr * 64 + m * 16 + fr;
                float s = 0.f;
#pragma unroll
                for (int bj = 0; bj < 2; ++bj) {
                    const size_t off = (size_t)row * DM + col0 + bj * 128;
                    const f32x4 v0 = r[m][bj][0] + acc[ai][bj][m][0], v1 = r[m][bj][1] + acc[ai][bj][m][1];
                    v4u w; w.x = pg8::cvt_pk_bf16(v0[0], v0[1]); w.y = pg8::cvt_pk_bf16(v0[2], v0[3]); w.z = pg8::cvt_pk_bf16(v1[0], v1[1]); w.w = pg8::cvt_pk_bf16(v1[2], v1[3]);
                    *(v4u*)(x1b + off) = w;
                    s += ((v0[0] * v0[0] + v0[1] * v0[1]) + (v0[2] * v0[2] + v0[3] * v0[3])) + ((v1[0] * v1[0] + v1[1] * v1[1]) + (v1[2] * v1[2] + v1[3] * v1[3]));
                }
                s += __shfl_xor(s, 16); s += __shfl_xor(s, 32);
                if (fq == 0) ss[(size_t)row * 16 + u.pn * 4 + wc] = s;
            }
            asm volatile("" ::: "memory");
        }
    }
};
struct EpiOut {
    static constexpr bool PERM = true;
    const bf16* x1; const float* ss1; const bf16* pp; float* out; bf16* xb; float* ss2; int last;
    __device__ __forceinline__ void operator()(const f32x4 (&acc)[2][2][4][2], const pg8::Unit& u, int wr, int wc, int fr, int fq) const {
        const int col0 = u.pn * 256 + wc * 32 + 8 * fq;
#pragma unroll
        for (int aim = 0; aim < 4; ++aim) {
            const int ai = aim >> 1, m0 = (aim & 1) * 2;
            v4u xw[4][2], pw[4][2]; f32x4 pt[4]; float rsv[4];
#pragma unroll
            for (int m = m0; m < m0 + 2; ++m) pt[m] = *(const f32x4*)(ss1 + (size_t)(u.pm * 256 + ai * 128 + wr * 64 + m * 16 + fr) * 16 + 4 * fq);
#pragma unroll
            for (int m = m0; m < m0 + 2; ++m)
#pragma unroll
                for (int bj = 0; bj < 2; ++bj) { const size_t off = (size_t)(u.pm * 256 + ai * 128 + wr * 64 + m * 16 + fr) * DM + col0 + bj * 128;
                    xw[m][bj] = *(const v4u*)(x1 + off); pw[m][bj] = *(const v4u*)(pp + off); }
#pragma unroll
            for (int m = m0; m < m0 + 2; ++m) { float t = (pt[m][0] + pt[m][1]) + (pt[m][2] + pt[m][3]); t += __shfl_xor(t, 16); t += __shfl_xor(t, 32); rsv[m] = rsqrtf(t * (1.f / 1024.f) + EPS); }
#pragma unroll
            for (int m = m0; m < m0 + 2; ++m) {
                const int row = u.pm * 256 + ai * 128 + wr * 64 + m * 16 + fr;
                const float rs = rsv[m];
                float s = 0.f;
#pragma unroll
                for (int bj = 0; bj < 2; ++bj) {
                    const size_t off = (size_t)row * DM + col0 + bj * 128;
                    const v4u x_ = xw[m][bj], p_ = pw[m][bj];
                    const f32x4 a0 = acc[ai][bj][m][0] * rs, a1 = acc[ai][bj][m][1] * rs;
                    f32x4 v0, v1;
                    v0[0] = bflo(x_.x) + sigmoidf_(a0[0]) * bflo(p_.x); v0[1] = bfhi(x_.x) + sigmoidf_(a0[1]) * bfhi(p_.x);
                    v0[2] = bflo(x_.y) + sigmoidf_(a0[2]) * bflo(p_.y); v0[3] = bfhi(x_.y) + sigmoidf_(a0[3]) * bfhi(p_.y);
                    v1[0] = bflo(x_.z) + sigmoidf_(a1[0]) * bflo(p_.z); v1[1] = bfhi(x_.z) + sigmoidf_(a1[1]) * bfhi(p_.z);
                    v1[2] = bflo(x_.w) + sigmoidf_(a1[2]) * bflo(p_.w); v1[3] = bfhi(x_.w) + sigmoidf_(a1[3]) * bfhi(p_.w);
                    *(f32x4*)(out + off) = v0; *(f32x4*)(out + off + 4) = v1;
                    if (!last) { v4u w; w.x = pg8::cvt_pk_bf16(v0[0], v0[1]); w.y = pg8::cvt_pk_bf16(v0[2], v0[3]); w.z = pg8::cvt_pk_bf16(v1[0], v1[1]); w.w = pg8::cvt_pk_bf16(v1[2], v1[3]);
                        *(v4u*)(xb + off) = w;
                        s += ((v0[0] * v0[0] + v0[1] * v0[1]) + (v0[2] * v0[2] + v0[3] * v0[3])) + ((v1[0] * v1[0] + v1[1] * v1[1]) + (v1[2] * v1[2] + v1[3] * v1[3])); }
                }
                if (!last) { s += __shfl_xor(s, 16); s += __shfl_xor(s, 32); if (fq == 0) ss2[(size_t)row * 16 + u.pn * 4 + wc] = s; }
            }
            asm volatile("" ::: "memory");
        }
    }
};

template <int MODE, bool HAS_SCALE>
__device__ __forceinline__ void transpose_item(const float* W, int K, int Nsrc, bf16* WT, const float* kscale, LAS float* scr, int item, int nblk, int lane) {
    const int kb = item / nblk, nb = item % nblk, k0 = 64 * kb, n0 = 32 * nb;
    const int n = n0 + (lane & 31);
    int sc = n; bool ok = true;
    if (MODE == 1) { sc = n < 1280 ? n : (n < 3328 ? n + 8 : n - 2048); ok = n < NIN; }
    const float okf = ok ? 1.f : 0.f; const int scc = ok ? sc : 0;
#pragma unroll 16
    for (int i = 0; i < 32; ++i) { const int kk = 2 * i + (lane >> 5); float v = W[(size_t)(k0 + kk) * Nsrc + scc] * okf; if (HAS_SCALE) v *= kscale[k0 + kk]; scr[kk * 33 + (lane & 31)] = v; }
    LDS_WAIT(); asm volatile("" ::: "memory");
    const int c = lane & 7;
#pragma unroll
    for (int j = 0; j < 4; ++j) { const int nn = (lane >> 3) + 8 * j; const LAS float* s = scr + (8 * c) * 33 + nn;
        v4u o; o.x = pk2(s[0 * 33], s[1 * 33]); o.y = pk2(s[2 * 33], s[3 * 33]); o.z = pk2(s[4 * 33], s[5 * 33]); o.w = pk2(s[6 * 33], s[7 * 33]);
        *(v4u*)(WT + (size_t)(n0 + nn) * K + k0 + 8 * c) = o; }
    LDS_WAIT(); asm volatile("" ::: "memory");
}
__device__ __forceinline__ void sincos_d(double a, float& s, float& c) {
    const double TWO_PI = 6.283185307179586476925;
    const double k = rint(a / TWO_PI); const double r = a - k * TWO_PI;
    const double h = 0.5 * r, h2 = h * h;
    const double sh = h * (1.0 + h2 * (-1.0 / 6.0 + h2 * (1.0 / 120.0 + h2 * (-1.0 / 5040.0 + h2 * (1.0 / 362880.0 + h2 * (-1.0 / 39916800.0 + h2 * (1.0 / 6227020800.0 + h2 * (-1.0 / 1307674368000.0 + h2 * (1.0 / 355687428096000.0 + h2 * (-1.0 / 121645100408832000.0))))))))));
    const double ch = 1.0 + h2 * (-0.5 + h2 * (1.0 / 24.0 + h2 * (-1.0 / 720.0 + h2 * (1.0 / 40320.0 + h2 * (-1.0 / 3628800.0 + h2 * (1.0 / 479001600.0 + h2 * (-1.0 / 87178291200.0 + h2 * (1.0 / 20922789888000.0 + h2 * (-1.0 / 6402373705728000.0 + h2 * (1.0 / 2432902008176640000.0))))))))));
    s = (float)(2.0 * sh * ch); c = (float)(1.0 - 2.0 * sh * sh);
}
__device__ __forceinline__ void p0_prologue(const Args& a, lds_t lds) {
    const int tid = opaque_tid(), lane = tid & 63, wave = tid >> 6, G = gridDim.x;
    unsigned char* ws = a.ws;
    LAS float* scr = (LAS float*)(lds + wave * 16384);
    const int gw = blockIdx.x * 8 + wave, NGW = G * 8;
    constexpr int I_IN = 16 * 112, I_OUT = 16 * 32, I_G = 16 * 32, I_PLE = 4 * 32, I_L = I_IN + I_OUT + I_G + I_PLE;
    for (int it = gw; it < 2 * I_L; it += NGW) {
        const int L = it / I_L; int r = it % I_L;
        if (r < I_IN) { transpose_item<1, true>(a.in[3] + (size_t)L * DM * NIN, DM, NIN, (bf16*)(ws + WS_WIN) + (size_t)L * ZP * DM, a.in[2] + L * DM, scr, r, 112, lane); continue; } r -= I_IN;
        if (r < I_OUT) { transpose_item<0, false>(a.in[4] + (size_t)L * DM * DM, DM, DM, (bf16*)(ws + WS_WOUT) + (size_t)L * DM * DM, nullptr, scr, r, 32, lane); continue; } r -= I_OUT;
        if (r < I_G) { transpose_item<0, true>(a.in[22] + (size_t)L * DM * DM, DM, DM, (bf16*)(ws + WS_WG) + (size_t)L * DM * DM, a.in[21] + L * DM, scr, r, 32, lane); continue; } r -= I_G;
        transpose_item<0, false>(a.in[20] + (size_t)L * 256 * DM, 256, DM, (bf16*)(ws + WS_WPLE) + (size_t)L * DM * 256, nullptr, scr, r, 32, lane);
    }
    float* ss0 = (float*)(ws + WS_CTL) + CW_SS0;
    for (int m = gw; m < M; m += 2 * NGW) {
        const int m2 = m + NGW;
        const f32x4* xr = (const f32x4*)(a.in[0] + (size_t)m * DM) + lane;
        const f32x4* xr2 = (const f32x4*)(a.in[0] + (size_t)(m2 < M ? m2 : m) * DM) + lane;
        f32x4 v[4], w[4];
#pragma unroll
        for (int j = 0; j < 4; ++j) { v[j] = xr[64 * j]; w[j] = xr2[64 * j]; }
        unsigned long long* o8 = (unsigned long long*)((bf16*)(ws + WS_XB) + (size_t)m * DM) + lane;
        unsigned long long* o82 = (unsigned long long*)((bf16*)(ws + WS_XB) + (size_t)(m2 < M ? m2 : m) * DM) + lane;
        float s = 0.f, s2 = 0.f;
#pragma unroll
        for (int j = 0; j < 4; ++j) {
            s += (v[j][0] * v[j][0] + v[j][1] * v[j][1]) + (v[j][2] * v[j][2] + v[j][3] * v[j][3]);
            s2 += (w[j][0] * w[j][0] + w[j][1] * w[j][1]) + (w[j][2] * w[j][2] + w[j][3] * w[j][3]);
            o8[64 * j] = (unsigned long long)pk2(v[j][0], v[j][1]) | ((unsigned long long)pk2(v[j][2], v[j][3]) << 32);
            if (m2 < M) o82[64 * j] = (unsigned long long)pk2(w[j][0], w[j][1]) | ((unsigned long long)pk2(w[j][2], w[j][3]) << 32);
        }
        s = wave_sum(s); s2 = wave_sum(s2);
        if (lane == 0) { ss0[m] = s; if (m2 < M) ss0[m2] = s2; }
    }
    const int gt = blockIdx.x * 512 + tid, NT = G * 512;
    for (int idx = gt; idx < 2 * 4 * 128 * 128; idx += NT) { const int i = (idx >> 7) & 127, j = idx & 127; ((bf16*)(ws + WS_CWS))[idx] = (bf16)f2bf(j <= i ? a.in[14][idx] : 0.f); }
    for (int idx = gt; idx < SEQ * 32; idx += NT) { const int pos = idx >> 5, j = idx & 31;
        const float inv = (float)exp(-(double)j * (1.0 / 32.0) * 9.210340371976182736);
        const float ang = (float)pos * inv; float s, c; sincos_d((double)ang, s, c);
        ((float*)(ws + WS_ROPE))[idx] = c; ((float*)(ws + WS_ROPE + MiB))[idx] = s; }
}

__device__ __forceinline__ void dn_prep(const Args& a, int layer, int item, lds_t lds) {
    const int tid = opaque_tid(), lane = tid & 63, wave = tid >> 6;
    const int h = item & 3, cn = (item >> 2) & 127, b = item >> 9;
    const int tok0 = b * SEQ + cn * 64;
    unsigned char* ws = a.ws;
    const bf16* Z = (const bf16*)(ws + WS_Z);
    const float* BA = (const float*)(ws + WS_BA);
    LAS float* Q = (LAS float*)lds;
    LAS float* Kk = Q + 64 * 68;
    LAS float* V = Kk + 64 * 68;
    LAS float* Ar = V + 64 * 68;
    LAS float* sm = Ar + 4096;
    lds_t img = lds + 71680;
    const float bl_pre = BA[(size_t)(tok0 + lane) * 8 + h], al_pre = BA[(size_t)(tok0 + lane) * 8 + 4 + h];
#pragma unroll
    for (int j = 0; j < 8; ++j) Ar[tid + 512 * j] = 0.f;
    *(LAS v4u*)(img + 24576 + tid * 16) = (v4u){0u, 0u, 0u, 0u};
    {
        const int t = tid >> 3, cg = tid & 7;
        const float* cw = a.in[8] + (size_t)layer * 4 * 768;
#pragma unroll
        for (int r = 0; r < 3; ++r) {
            const int ch0 = r * 256 + h * 64 + cg * 8;
            float acc[8];
#pragma unroll
            for (int j = 0; j < 8; ++j) acc[j] = 0.f;
#pragma unroll
            for (int k = 0; k < 4; ++k) {
                const int row = t - 3 + k;
                const bool okr = cn * 64 + row >= 0; const float kf = okr ? 1.f : 0.f;
                {
                    const v4u w = *(const v4u*)(Z + (size_t)(tok0 + (okr ? row : 0)) * ZP + 512 + ch0);
                    float x[8]; UNPACK8(w, x, 0);
                    const f32x4 w0 = *(const f32x4*)(cw + k * 768 + ch0) * kf, w1 = *(const f32x4*)(cw + k * 768 + ch0 + 4) * kf;
                    acc[0] += w0[0] * x[0]; acc[1] += w0[1] * x[1]; acc[2] += w0[2] * x[2]; acc[3] += w0[3] * x[3];
                    acc[4] += w1[0] * x[4]; acc[5] += w1[1] * x[5]; acc[6] += w1[2] * x[6]; acc[7] += w1[3] * x[7];
                }
            }
            float ss = 0.f;
#pragma unroll
            for (int j = 0; j < 8; ++j) { acc[j] = siluf_(acc[j]); ss += acc[j] * acc[j]; }
            if (r < 2) {
                ss += __shfl_xor(ss, 1); ss += __shfl_xor(ss, 2); ss += __shfl_xor(ss, 4);
                const float sc = rsqrtf(ss + EPS) * (r == 0 ? 0.125f : 1.f);
#pragma unroll
                for (int j = 0; j < 8; ++j) acc[j] *= sc;
            }
            LAS float* dst = (r == 0 ? Q : (r == 1 ? Kk : V)) + t * 68 + cg * 8;
            *(LAS f32x4*)dst = (f32x4){acc[0], acc[1], acc[2], acc[3]};
            *(LAS f32x4*)(dst + 4) = (f32x4){acc[4], acc[5], acc[6], acc[7]};
        }
    }
    if (wave == 0) {
        const int t = lane;
        const float bl = bl_pre, al = al_pre;
        const float beta = sigmoidf_(bl);
        const float xx = al + a.in[10][layer * 4 + h];
        const float sp = xx > 20.f ? xx : log1pf(expf(xx));
        float gd = -expf(a.in[9][layer * 4 + h]) * sp;
#pragma unroll
        for (int off = 1; off < 64; off <<= 1) { const float y = __shfl_up(gd, off); if (lane >= off) gd += y; }
        const float gl = __shfl(gd, 63);
        const float eg = expf(gd);
        sm[t] = beta; sm[64 + t] = gd; sm[128 + t] = eg; sm[192 + t] = beta * eg; sm[256 + t] = expf(gl - gd);
        if (lane == 63) ((float*)(ws + WS_CDEC))[item] = eg;
    }
    __syncthreads();
    {
        const int ql = lane & 15, g = lane >> 4;
#pragma unroll
        for (int rr = 0; rr < 3; ++rr) {
            const int tk = wave + 8 * rr;
            if (tk < 20) {
                const int kind = tk / 10, idx = tk % 10;
                const int it = idx < 1 ? 0 : (idx < 3 ? 1 : (idx < 6 ? 2 : 3)), jt = idx - (it * (it + 1)) / 2;
                const LAS float* As = (kind == 0 ? Kk : Q) + (16 * it + ql) * 68 + 16 * g;
                const LAS float* Bs = Kk + (16 * jt + ql) * 68 + 16 * g;
                f32x4 av[4], bv[4];
#pragma unroll
                for (int q = 0; q < 4; ++q) { av[q] = *(const LAS f32x4*)(As + 4 * q); bv[q] = *(const LAS f32x4*)(Bs + 4 * q); }
                f32x4 acc = (f32x4){0.f, 0.f, 0.f, 0.f};
#pragma unroll
                for (int q = 0; q < 4; ++q)
#pragma unroll
                    for (int e = 0; e < 4; ++e) acc = __builtin_amdgcn_mfma_f32_16x16x4f32(av[q][e], bv[q][e], acc, 0, 0, 0);
                const int j = 16 * jt + ql; const float gcj = sm[64 + j];
#pragma unroll
                for (int e = 0; e < 4; ++e) {
                    const int i = 16 * it + 4 * g + e;
                    const float df = sm[64 + i] - gcj;
                    if (kind == 0) { const float v = (i > j) ? sm[i] * acc[e] * __expf(df) : 0.f; Ar[i * 64 + (j & 3) * 16 + (j >> 2)] = v; }
                    else { const float v = (i >= j) ? acc[e] * __expf(df) : 0.f; *(LAS bf16*)(img + 24576 + 2 * frag_off_perm(i, j)) = (bf16)f2bf(v); }
                }
            }
        }
    }
    __syncthreads();
    {
        LAS float* Xs = (LAS float*)(lds + 120832);
        LAS float* Ys = (LAS float*)(lds + 137216);
        LAS float* Ti = (LAS float*)(lds + 145408);
        if (wave < 4 && lane < 16) {
            const int bb = wave, c = lane;
            float t[16];
#pragma unroll
            for (int i = 0; i < 16; ++i) {
                float acc = (i == c) ? 1.f : 0.f;
#pragma unroll
                for (int k = 0; k < 16; ++k) if (k < i) acc -= Ar[(16 * bb + i) * 64 + (k & 3) * 16 + 4 * bb + (k >> 2)] * t[k];
                t[i] = acc;
                Ti[bb * 256 + i * 16 + (c & 3) * 4 + (c >> 2)] = acc;
            }
        }
        __syncthreads();
        {
            const int ql = lane & 15, kq = lane >> 4, w = wave;
            LAS float* Xb = (w < 4) ? (LAS float*)(img + 32768 + w * 4096) : (Xs + (w - 4) * 1024);
            LAS float* Yw = Ys + w * 256;
            const LAS float* Rsrc = (w < 4) ? (V + 16 * w + ql) : (Kk + 16 * (w - 4) + ql);
            const LAS float* Rscl = (w < 4) ? sm : (sm + 192);
#pragma unroll
            for (int bb = 0; bb < 4; ++bb) {
                f32x4 acc = (f32x4){0.f, 0.f, 0.f, 0.f};
#pragma unroll
                for (int j = 0; j < 4; ++j) if (j < bb) {
                    const f32x4 av = *(const LAS f32x4*)(Ar + (16 * bb + ql) * 64 + kq * 16 + 4 * j);
#pragma unroll
                    for (int q = 0; q < 4; ++q) acc = __builtin_amdgcn_mfma_f32_16x16x4f32(av[q], Xb[j * 256 + (q * 16 + ql) * 4 + kq], acc, 0, 0, 0);
                }
                f32x4 y;
#pragma unroll
                for (int e = 0; e < 4; ++e) { const int row = 16 * bb + 4 * kq + e; y[e] = Rsrc[row * 68] * Rscl[row] - acc[e]; }
#pragma unroll
                for (int e = 0; e < 4; ++e) Yw[(4 * kq + e) * 16 + ql] = y[e];
                LDS_WAIT(); asm volatile("" ::: "memory");
                const f32x4 tv = *(const LAS f32x4*)(Ti + bb * 256 + ql * 16 + kq * 4);
                f32x4 x = (f32x4){0.f, 0.f, 0.f, 0.f};
#pragma unroll
                for (int q = 0; q < 4; ++q) x = __builtin_amdgcn_mfma_f32_16x16x4f32(tv[q], Yw[(4 * q + kq) * 16 + ql], x, 0, 0, 0);
                *(LAS f32x4*)(Xb + bb * 256 + lane * 4) = x;
                if (w >= 4) {
#pragma unroll
                    for (int e = 0; e < 4; ++e) *(LAS bf16*)(img + 2 * frag_off_perm(16 * bb + 4 * kq + e, 16 * (w - 4) + ql)) = (bf16)f2bf(x[e]);
                }
                LDS_WAIT(); asm volatile("" ::: "memory");
            }
        }
    }
#pragma unroll
    for (int j = 0; j < 8; ++j) {
        const int idx = tid + 512 * j, i = idx >> 6, d = idx & 63;
        *(LAS bf16*)(img + 8192 + 2 * frag_off_perm(i, d)) = (bf16)f2bf(Q[i * 68 + d] * sm[128 + i]);
        *(LAS bf16*)(img + 16384 + 2 * frag_off_perm(d, i)) = (bf16)f2bf(Kk[i * 68 + d] * sm[256 + i]);
    }
    __syncthreads();
    {
        unsigned char* dst = ws + WS_DN + (size_t)item * DN_ITEM;
#pragma unroll
        for (int j = 0; j < 6; ++j) { const int p = tid + 512 * j; *(v4u*)(dst + p * 16) = *(const LAS v4u*)(img + p * 16); }
    }
    __syncthreads();
}

__device__ __forceinline__ void glds16(const void* gsrc, unsigned lds_dst) { unsigned keep; lds_dst = __builtin_amdgcn_readfirstlane(lds_dst);
    asm volatile("s_mov_b32 %0, m0\n\ts_mov_b32 m0, %2\n\ts_nop 0\n\tglobal_load_lds_dwordx4 %1, off\n\ts_mov_b32 m0, %0" : "=&s"(keep) : "v"(gsrc), "s"(lds_dst) : "memory"); }
constexpr int SCAN_SLOT = 36864, SCAN_CD_OFF = 4 * SCAN_SLOT, SCAN_HB_OFF = SCAN_CD_OFF + 512;
__device__ __forceinline__ void dn_scan(const Args& a, int bh, int slice, lds_t lds) {
    const int tid = opaque_tid(), lane = tid & 63, wave = __builtin_amdgcn_readfirstlane(tid >> 6);
    const int b = bh >> 2, h = bh & 3;
    unsigned char* ws = opaque_ptr(a.ws);
    const unsigned char* DN = ws + WS_DN;
    LAS float* cd = (LAS float*)(lds + SCAN_CD_OFF);
    if (tid < 128) cd[tid] = ((const float*)(ws + WS_CDEC))[(b * 128 + tid) * 4 + h];
    __syncthreads();
    const bool stager = wave >= 2;
    const int pc0 = (wave - 2) * 6;
    const unsigned ldsbase = (unsigned)(size_t)lds;
#define SCAN_ISSUE(n, slot) do { if (stager) { const int _n = (n) < 128 ? (n) : 127; const unsigned char* _s = DN + (size_t)((b * 128 + _n) * 4 + h) * DN_ITEM + lane * 16; \
        _Pragma("unroll") for (int _j = 0; _j < 6; ++_j) { const int _pc = pc0 + _j; const int _go = _pc < 32 ? _pc * 1024 : 32768 + slice * 4096 + (_pc - 32) * 1024; \
            glds16(_s + _go, ldsbase + (slot) * SCAN_SLOT + _pc * 1024); } } } while (0)
#define SCAN_BAR6() do { if (stager) asm volatile("s_waitcnt vmcnt(6)" ::: "memory"); asm volatile("s_waitcnt lgkmcnt(0)" ::: "memory"); __builtin_amdgcn_s_barrier(); asm volatile("" ::: "memory"); } while (0)
    SCAN_ISSUE(0, 0); SCAN_ISSUE(1, 1);
    SCAN_BAR6();
    f32x4 S[4];
#pragma unroll
    for (int t = 0; t < 4; ++t) S[t] = (f32x4){0.f, 0.f, 0.f, 0.f};
    const int g = lane >> 4, ql = lane & 15;
    float* OB = (float*)((unsigned char*)(ws + WS_Z) + 1024) + h * 64 + slice * 16 + ql;
#define MF(A, B, C) __builtin_amdgcn_mfma_f32_16x16x32_bf16(A, B, C, 0, 0, 0)
#define SCAN_W0(n, slot, hb) do { if (wave == 0) { \
        const lds_t bp = lds + (slot) * SCAN_SLOT + lane * 16; const lds_t hp = lds + SCAN_HB_OFF + (hb) * 4096 + lane * 16; \
        bf16x8 fw[8], fg[8]; f32x4 uu[4]; \
        _Pragma("unroll") for (int i = 0; i < 8; ++i) fw[i] = *(const LAS bf16x8*)(bp + i * 1024); \
        _Pragma("unroll") for (int t = 0; t < 4; ++t) uu[t] = *(const LAS f32x4*)(bp + 32768 + t * 1024); \
        _Pragma("unroll") for (int i = 0; i < 8; ++i) fg[i] = *(const LAS bf16x8*)(bp + 16384 + i * 1024); \
        const float dec = cd[(n)]; \
        const bf16x8 Sb0 = pack8(S[0], S[1]), Sb1 = pack8(S[2], S[3]); \
        *(LAS bf16x8*)(hp) = Sb0; *(LAS bf16x8*)(hp + 1024) = Sb1; \
        f32x4 vn[4]; const f32x4 zz = (f32x4){0.f, 0.f, 0.f, 0.f}; \
        _Pragma("unroll") for (int t = 0; t < 4; ++t) vn[t] = MF(fw[2 * t], Sb0, zz); \
        _Pragma("unroll") for (int t = 0; t < 4; ++t) vn[t] = uu[t] - MF(fw[2 * t + 1], Sb1, vn[t]); \
        const bf16x8 Vb0 = pack8(vn[0], vn[1]), Vb1 = pack8(vn[2], vn[3]); \
        *(LAS bf16x8*)(hp + 2048) = Vb0; *(LAS bf16x8*)(hp + 3072) = Vb1; \
        _Pragma("unroll") for (int t = 0; t < 4; ++t) S[t] = MF(fg[2 * t], Vb0, S[t] * dec); \
        _Pragma("unroll") for (int t = 0; t < 4; ++t) S[t] = MF(fg[2 * t + 1], Vb1, S[t]); \
    } } while (0)
#define SCAN_W1(n, slot, hb) do { if (wave == 1 && (n) >= 0) { \
        const lds_t bp = lds + (slot) * SCAN_SLOT + lane * 16; const lds_t hp = lds + SCAN_HB_OFF + (hb) * 4096 + lane * 16; \
        bf16x8 fq[8], fk[8]; \
        _Pragma("unroll") for (int i = 0; i < 8; ++i) fq[i] = *(const LAS bf16x8*)(bp + 8192 + i * 1024); \
        _Pragma("unroll") for (int i = 0; i < 8; ++i) fk[i] = *(const LAS bf16x8*)(bp + 24576 + i * 1024); \
        const bf16x8 Sb0 = *(const LAS bf16x8*)(hp), Sb1 = *(const LAS bf16x8*)(hp + 1024), Vb0 = *(const LAS bf16x8*)(hp + 2048), Vb1 = *(const LAS bf16x8*)(hp + 3072); \
        f32x4 oo[4]; const f32x4 zz = (f32x4){0.f, 0.f, 0.f, 0.f}; \
        _Pragma("unroll") for (int t = 0; t < 4; ++t) oo[t] = MF(fq[2 * t], Sb0, zz); \
        _Pragma("unroll") for (int t = 0; t < 4; ++t) oo[t] = MF(fq[2 * t + 1], Sb1, oo[t]); \
        _Pragma("unroll") for (int t = 0; t < 4; ++t) oo[t] = MF(fk[2 * t], Vb0, oo[t]); \
        _Pragma("unroll") for (int t = 0; t < 4; ++t) oo[t] = MF(fk[2 * t + 1], Vb1, oo[t]); \
        const size_t tokb = (size_t)b * SEQ + (size_t)(n) * 64; \
        _Pragma("unroll") for (int t = 0; t < 4; ++t) \
            _Pragma("unroll") for (int e = 0; e < 4; ++e) *(float*)((unsigned char*)OB + (tokb + 16 * t + 4 * g + e) * (size_t)(ZP * 2)) = oo[t][e]; \
    } } while (0)
#pragma unroll 1
    for (int n0 = 0; n0 < 128; n0 += 4) {
        SCAN_ISSUE(n0 + 2, 2); SCAN_W0(n0 + 0, 0, 0); SCAN_W1(n0 - 1, 3, 1); SCAN_BAR6();
        SCAN_ISSUE(n0 + 3, 3); SCAN_W0(n0 + 1, 1, 1); SCAN_W1(n0 + 0, 0, 0); SCAN_BAR6();
        SCAN_ISSUE(n0 + 4, 0); SCAN_W0(n0 + 2, 2, 0); SCAN_W1(n0 + 1, 1, 1); SCAN_BAR6();
        SCAN_ISSUE(n0 + 5, 1); SCAN_W0(n0 + 3, 3, 1); SCAN_W1(n0 + 2, 2, 0); SCAN_BAR6();
    }
    SCAN_W1(127, 3, 1);
#undef SCAN_ISSUE
#undef SCAN_W0
#undef SCAN_W1
#undef SCAN_BAR6
#undef MF
    asm volatile("s_waitcnt vmcnt(0)" ::: "memory");
    __syncthreads();
}

__device__ __forceinline__ void mixer_a(const Args& a, int layer, int item, lds_t lds) {
    const int tid = opaque_tid(), lane = tid & 63, wave = tid >> 6;
    const int kvh = item & 1, blk = (item >> 1) & 63, b = item >> 7;
    unsigned char* ws = a.ws;
    const bf16* Z = (const bf16*)(ws + WS_Z);
    bf16* MIX = (bf16*)(ws + WS_XB);
    const float* cosT = (const float*)(ws + WS_ROPE); const float* sinT = (const float*)(ws + WS_ROPE + MiB);
    const float* qgain = a.in[5] + layer * 64; const float* kgain = a.in[6] + layer * 64; const float* sink = a.in[7] + layer * 4;
    LAS bf16* Kl = (LAS bf16*)lds;
    LAS bf16* Vt = (LAS bf16*)(lds + 36864);
    v4u vw[4]; bool vvalid; int vkk, vdh;
    {
        vkk = tid & 255; vdh = tid >> 8; const int kt = blk * 128 - 128 + vkk; vvalid = kt >= 0;
        const v4u* src = (const v4u*)(Z + (size_t)(b * SEQ + (vvalid ? kt : 0)) * ZP + 384 + kvh * 64 + 32 * vdh);
#pragma unroll
        for (int q = 0; q < 4; ++q) vw[q] = src[q];
    }
    {
        const int kk = tid >> 1, hf = tid & 1; const int kt = blk * 128 - 128 + kk; const bool valid = kt >= 0;
        float xa[16], xb[16];
        { const bf16* src = Z + (size_t)(b * SEQ + (valid ? kt : 0)) * ZP + 256 + kvh * 64 + 16 * hf;
            const v4u w0 = *(const v4u*)src, w1 = *(const v4u*)(src + 8), w2 = *(const v4u*)(src + 32), w3 = *(const v4u*)(src + 40);
            UNPACK8(w0, xa, 0); UNPACK8(w1, xa, 8); UNPACK8(w2, xb, 0); UNPACK8(w3, xb, 8); }
        if (!valid) {
#pragma unroll
            for (int j = 0; j < 16; ++j) { xa[j] = 0.f; xb[j] = 0.f; } }
        float ss = 0.f;
#pragma unroll
        for (int j = 0; j < 16; ++j) ss += xa[j] * xa[j] + xb[j] * xb[j];
        ss += __shfl_xor(ss, 1);
        const float rs = rsqrtf(ss * (1.f / 64.f) + EPS);
        const int kp = valid ? kt : 0;
#pragma unroll
        for (int j = 0; j < 16; ++j) {
            const float c = cosT[kp * 32 + 16 * hf + j], sn = sinT[kp * 32 + 16 * hf + j];
            const float x1 = xa[j] * rs * kgain[16 * hf + j], x2 = xb[j] * rs * kgain[32 + 16 * hf + j];
            xa[j] = x1 * c - x2 * sn; xb[j] = x2 * c + x1 * sn;
        }
        v4u w;
        w.x = pk2(xa[0], xa[1]); w.y = pk2(xa[2], xa[3]); w.z = pk2(xa[4], xa[5]); w.w = pk2(xa[6], xa[7]); *(LAS v4u*)(Kl + kk * 72 + 16 * hf) = w;
        w.x = pk2(xa[8], xa[9]); w.y = pk2(xa[10], xa[11]); w.z = pk2(xa[12], xa[13]); w.w = pk2(xa[14], xa[15]); *(LAS v4u*)(Kl + kk * 72 + 16 * hf + 8) = w;
        w.x = pk2(xb[0], xb[1]); w.y = pk2(xb[2], xb[3]); w.z = pk2(xb[4], xb[5]); w.w = pk2(xb[6], xb[7]); *(LAS v4u*)(Kl + kk * 72 + 32 + 16 * hf) = w;
        w.x = pk2(xb[8], xb[9]); w.y = pk2(xb[10], xb[11]); w.z = pk2(xb[12], xb[13]); w.w = pk2(xb[14], xb[15]); *(LAS v4u*)(Kl + kk * 72 + 32 + 16 * hf + 8) = w;
    }
    {
        const int kk = vkk, dh = vdh;
        v4u w[4];
#pragma unroll
        for (int q = 0; q < 4; ++q) w[q] = vvalid ? vw[q] : (v4u){0u, 0u, 0u, 0u};
        LAS bf16* vt = Vt + (32 * dh) * 280 + kk;
#pragma unroll
        for (int q = 0; q < 4; ++q) {
            vt[(8 * q + 0) * 280] = (bf16)(w[q][0] & 0xffffu); vt[(8 * q + 1) * 280] = (bf16)(w[q][0] >> 16);
            vt[(8 * q + 2) * 280] = (bf16)(w[q][1] & 0xffffu); vt[(8 * q + 3) * 280] = (bf16)(w[q][1] >> 16);
            vt[(8 * q + 4) * 280] = (bf16)(w[q][2] & 0xffffu); vt[(8 * q + 5) * 280] = (bf16)(w[q][2] >> 16);
            vt[(8 * q + 6) * 280] = (bf16)(w[q][3] & 0xffffu); vt[(8 * q + 7) * 280] = (bf16)(w[q][3] >> 16);
        }
        if (kk < 24) {
#pragma unroll 8
            for (int d = 0; d < 32; ++d) Vt[(32 * dh + d) * 280 + 256 + kk] = (bf16)0;
        }
    }
    __syncthreads();
    const int ql = lane & 15, g = lane >> 4;
#pragma unroll
    for (int rr = 0; rr < 2; ++rr) {
        const int task = wave + 8 * rr, hl = task >> 3, qt = task & 7, h = kvh * 2 + hl;
        const int tq = blk * 128 + qt * 16 + ql; const size_t tok = (size_t)b * SEQ + tq;
        bf16x8 Qb0, Qb1;
        {
            const v4u w1 = *(const v4u*)(Z + tok * ZP + h * 64 + 8 * g), w2 = *(const v4u*)(Z + tok * ZP + h * 64 + 32 + 8 * g);
            float x1[8], x2[8]; UNPACK8(w1, x1, 0); UNPACK8(w2, x2, 0);
            float ss = 0.f;
#pragma unroll
            for (int j = 0; j < 8; ++j) ss += x1[j] * x1[j] + x2[j] * x2[j];
            ss += __shfl_xor(ss, 16); ss += __shfl_xor(ss, 32);
            const float rs = rsqrtf(ss * (1.f / 64.f) + EPS) * 0.125f;
            float o1[8], o2[8];
#pragma unroll
            for (int j = 0; j < 8; ++j) {
                const float c = cosT[tq * 32 + 8 * g + j], s = sinT[tq * 32 + 8 * g + j];
                const float y1 = x1[j] * rs * qgain[8 * g + j], y2 = x2[j] * rs * qgain[32 + 8 * g + j];
                o1[j] = y1 * c - y2 * s; o2[j] = y2 * c + y1 * s;
            }
            Qb0 = pack8((f32x4){o1[0], o1[1], o1[2], o1[3]}, (f32x4){o1[4], o1[5], o1[6], o1[7]});
            Qb1 = pack8((f32x4){o2[0], o2[1], o2[2], o2[3]}, (f32x4){o2[4], o2[5], o2[6], o2[7]});
        }
        f32x4 sc[9];
#pragma unroll
        for (int t = 0; t < 9; ++t) {
            const LAS bf16* kp = Kl + (16 * (qt + t) + ql) * 72 + 8 * g;
            f32x4 acc = (f32x4){0.f, 0.f, 0.f, 0.f};
            acc = __builtin_amdgcn_mfma_f32_16x16x32_bf16(*(const LAS bf16x8*)kp, Qb0, acc, 0, 0, 0);
            acc = __builtin_amdgcn_mfma_f32_16x16x32_bf16(*(const LAS bf16x8*)(kp + 32), Qb1, acc, 0, 0, 0);
            sc[t] = acc;
        }
        float mx = -INFINITY;
#pragma unroll
        for (int t = 0; t < 9; ++t)
#pragma unroll
            for (int e = 0; e < 4; ++e) {
                const int rel = 128 + ql - 16 * t - 4 * g - e, kj = 16 * (qt + t) + 4 * g + e;
                const bool ok = (rel >= 0) && (rel < 128) && (blk > 0 || kj >= 128);
                const float v = ok ? sc[t][e] : -INFINITY; sc[t][e] = v; mx = fmaxf(mx, v);
            }
        mx = fmaxf(mx, __shfl_xor(mx, 16)); mx = fmaxf(mx, __shfl_xor(mx, 32));
        const float sk = sink[h]; const float mm = fmaxf(mx, sk);
        float sum = 0.f;
#pragma unroll
        for (int t = 0; t < 9; ++t)
#pragma unroll
            for (int e = 0; e < 4; ++e) { const float ev = __expf(sc[t][e] - mm); sc[t][e] = ev; sum += ev; }
        sum += __shfl_xor(sum, 16); sum += __shfl_xor(sum, 32);
        const float inv = 1.f / (sum + __expf(sk - mm));
        f32x4 o[4];
#pragma unroll
        for (int dt = 0; dt < 4; ++dt) o[dt] = (f32x4){0.f, 0.f, 0.f, 0.f};
#pragma unroll
        for (int ks = 0; ks < 5; ++ks) {
            const f32x4 plo = sc[2 * ks] * inv;
            const f32x4 phi = (2 * ks + 1 < 9) ? sc[(2 * ks + 1 < 9) ? 2 * ks + 1 : 8] * inv : (f32x4){0.f, 0.f, 0.f, 0.f};
            const bf16x8 Pb = pack8(plo, phi);
#pragma unroll
            for (int dt = 0; dt < 4; ++dt) {
                const LAS bf16* vp = Vt + (16 * dt + ql) * 280 + 16 * (qt + 2 * ks) + 4 * g;
                const v2u lo = *(const LAS v2u*)vp, hi = *(const LAS v2u*)(vp + 16);
                const v4u av = (v4u){lo.x, lo.y, hi.x, hi.y};
                o[dt] = __builtin_amdgcn_mfma_f32_16x16x32_bf16(__builtin_bit_cast(bf16x8, av), Pb, o[dt], 0, 0, 0);
            }
        }
#pragma unroll
        for (int dt = 0; dt < 4; ++dt) {
            const int col = h * 64 + 16 * dt + 4 * g;
            const v2u gw = *(const v2u*)(Z + tok * ZP + ZC_GATE + col);
            v2u w; w.x = pk2(o[dt][0] * siluf_(bflo(gw.x)), o[dt][1] * siluf_(bfhi(gw.x))); w.y = pk2(o[dt][2] * siluf_(bflo(gw.y)), o[dt][3] * siluf_(bfhi(gw.y)));
            *(v2u*)(MIX + tok * DM + col) = w;
        }
    }
    __syncthreads();
}

__device__ __forceinline__ void mixer_c(const Args& a, int layer, int item, lds_t lds) {
    const int tid = opaque_tid(), lane = tid & 63, wave = tid >> 6;
    const int b = item >> 6, cn = item & 63; const size_t tok0 = (size_t)b * SEQ + cn * 128;
    unsigned char* ws = a.ws;
    const bf16* Z = (const bf16*)(ws + WS_Z);
    bf16* MIX = (bf16*)(ws + WS_XB);
    const bf16* CWS = (const bf16*)(ws + WS_CWS);
    LAS bf16* Vt = (LAS bf16*)lds;
    {
        const int t = tid >> 2, q = tid & 3; const size_t tok = tok0 + t;
        const v4u* src = (const v4u*)(Z + tok * ZP + 1536 + 64 * q);
        float x[64];
#pragma unroll
        for (int k = 0; k < 8; ++k) { const v4u w = src[k]; UNPACK8(w, x, 8 * k); }
        float s = 0.f;
#pragma unroll
        for (int j = 0; j < 64; ++j) { x[j] = geluf_(x[j]); s += x[j]; }
        s = quad_sum(s); const float mean = s * (1.f / 256.f);
        float s2 = 0.f;
#pragma unroll
        for (int j = 0; j < 64; ++j) { x[j] -= mean; s2 += x[j] * x[j]; }
        s2 = quad_sum(s2); const float rstd = rsqrtf(s2 * (1.f / 256.f) + EPS);
        const float* gn = a.in[12] + layer * 256 + 64 * q; const float* bs = a.in[13] + layer * 256 + 64 * q;
#pragma unroll
        for (int j = 0; j < 64; ++j) Vt[(64 * q + j) * 136 + (t ^ (((j >> 4) & 3) * 32))] = (bf16)f2bf(x[j] * rstd * gn[j] + bs[j]);
    }
    __syncthreads();
    {
        const int gq = wave >> 1, par = wave & 1, ql = lane & 15, g = lane >> 4;
#pragma unroll
        for (int ii = 0; ii < 4; ++ii) {
            const int it = par + 2 * ii, nks = (it >> 1) + 1;
            f32x4 acc[4];
#pragma unroll
            for (int ct = 0; ct < 4; ++ct) acc[ct] = (f32x4){0.f, 0.f, 0.f, 0.f};
            for (int ks = 0; ks < nks; ++ks) {
                const bf16x8 Bv = *(const bf16x8*)(CWS + ((size_t)((layer * 4 + gq) * 128 + 16 * it + ql)) * 128 + 32 * ks + 8 * g);
#pragma unroll
                for (int ct = 0; ct < 4; ++ct) {
                    const bf16x8 Av = *(const LAS bf16x8*)(Vt + (gq * 64 + 16 * (ql >> 2) + 4 * ct + (ql & 3)) * 136 + ((32 * ks + 8 * g) ^ ((ql >> 2) * 32)));
                    acc[ct] = __builtin_amdgcn_mfma_f32_16x16x32_bf16(Av, Bv, acc[ct], 0, 0, 0);
                }
            }
            const int ti = 16 * it + ql; const size_t tok = tok0 + ti;
            const float bsv = a.in[15][(layer * 4 + gq) * 128 + ti];
            {
                const int c0 = gq * 64 + 16 * g;
                const v4u u0 = *(const v4u*)(Z + tok * ZP + 1280 + c0), u1 = *(const v4u*)(Z + tok * ZP + 1280 + c0 + 8);
                const v4u g0 = *(const v4u*)(Z + tok * ZP + ZC_GATE + 512 + c0), g1 = *(const v4u*)(Z + tok * ZP + ZC_GATE + 512 + c0 + 8);
                float uv[16], gv[16], ov[16];
                UNPACK8(u0, uv, 0); UNPACK8(u1, uv, 8); UNPACK8(g0, gv, 0); UNPACK8(g1, gv, 8);
#pragma unroll
                for (int ct = 0; ct < 4; ++ct)
#pragma unroll
                    for (int e = 0; e < 4; ++e) ov[4 * ct + e] = geluf_(uv[4 * ct + e]) * (acc[ct][e] + bsv) * siluf_(gv[4 * ct + e]);
                v4u w0, w1;
                w0.x = pk2(ov[0], ov[1]); w0.y = pk2(ov[2], ov[3]); w0.z = pk2(ov[4], ov[5]); w0.w = pk2(ov[6], ov[7]);
                w1.x = pk2(ov[8], ov[9]); w1.y = pk2(ov[10], ov[11]); w1.z = pk2(ov[12], ov[13]); w1.w = pk2(ov[14], ov[15]);
                *(v4u*)(MIX + tok * DM + 512 + c0) = w0; *(v4u*)(MIX + tok * DM + 512 + c0 + 8) = w1;
            }
        }
    }
    __syncthreads();
}

__device__ __forceinline__ void mixer_d(const Args& a, int layer, int item, lds_t lds) {
    const int tid = opaque_tid(), lane = tid & 63, wave = tid >> 6;
    const int ch = item & 1, tn = (item >> 1) & 63, b = item >> 7; const int t0s = tn * 128;
    unsigned char* ws = a.ws;
    const bf16* Z = (const bf16*)(ws + WS_Z);
    bf16* MIX = (bf16*)(ws + WS_XB);
    LAS float* Y = (LAS float*)lds;
    {
        v4u aw[5], gw[5]; int rowv[5], cgv[5]; float okv[5];
#pragma unroll
        for (int it5 = 0; it5 < 5; ++it5) {
            const int task = tid + 512 * it5; const bool tv = task < 158 * 16; const int tk = tv ? task : 0;
            const int row = tk >> 4, cg = tk & 15; const int sp = t0s - 30 + row; const bool okb = tv && sp >= 0;
            const size_t tok = (size_t)b * SEQ + (okb ? sp : 0);
            aw[it5] = *(const v4u*)(Z + tok * ZP + 1792 + ch * 128 + cg * 8); gw[it5] = *(const v4u*)(Z + tok * ZP + 2048 + ch * 128 + cg * 8);
            rowv[it5] = tv ? row : -1; cgv[it5] = cg; okv[it5] = okb ? 1.f : 0.f;
        }
#pragma unroll
        for (int it5 = 0; it5 < 5; ++it5) {
            float av[8], gv[8]; UNPACK8(aw[it5], av, 0); UNPACK8(gw[it5], gv, 0);
            const float k = okv[it5];
            const f32x4 y0 = (f32x4){k * av[0] * sigmoidf_(gv[0]), k * av[1] * sigmoidf_(gv[1]), k * av[2] * sigmoidf_(gv[2]), k * av[3] * sigmoidf_(gv[3])};
            const f32x4 y1 = (f32x4){k * av[4] * sigmoidf_(gv[4]), k * av[5] * sigmoidf_(gv[5]), k * av[6] * sigmoidf_(gv[6]), k * av[7] * sigmoidf_(gv[7])};
            if (rowv[it5] >= 0) { *(LAS f32x4*)(Y + rowv[it5] * 128 + cgv[it5] * 8) = y0; *(LAS f32x4*)(Y + rowv[it5] * 128 + cgv[it5] * 8 + 4) = y1; }
        }
    }
    __syncthreads();
    {
        const int gl = wave & 1, tq = wave >> 1, cl = gl * 64 + lane, c = ch * 128 + cl;
        float w[31];
#pragma unroll
        for (int k = 0; k < 31; ++k) w[k] = a.in[16][((size_t)layer * 31 + k) * 256 + c];
        const float bias = a.in[17][layer * 256 + c], lng = a.in[18][layer * 256 + c], lnb = a.in[19][layer * 256 + c];
#pragma unroll 1
        for (int run = 0; run < 4; ++run) {
            const int tb = tq * 32 + run * 8;
            float acc[8];
#pragma unroll
            for (int o = 0; o < 8; ++o) acc[o] = bias;
#pragma unroll
            for (int r = 0; r < 38; ++r) {
                const float yv = Y[(tb + r) * 128 + cl];
#pragma unroll
                for (int o = 0; o < 8; ++o) { if (r - o >= 0 && r - o <= 30) acc[o] += w[(r - o >= 0 && r - o <= 30) ? r - o : 0] * yv; }
            }
#pragma unroll
            for (int o = 0; o < 8; ++o) {
                const float mean = wave_sum_dpp(acc[o]) * (1.f / 64.f);
                const float d = acc[o] - mean;
                const float var = wave_sum_dpp(d * d) * (1.f / 64.f);
                float y = d * rsqrtf(var + EPS) * lng + lnb;
                y = siluf_(y);
                const size_t tok = (size_t)b * SEQ + t0s + tb + o;
                const float gt = bflo((unsigned)Z[tok * ZP + ZC_GATE + 768 + c]);
                MIX[tok * DM + 768 + c] = (bf16)f2bf(y * siluf_(gt));
            }
        }
    }
    __syncthreads();
}

__device__ __forceinline__ void finalize_b(const Args& a, int layer) {
    unsigned char* ws = a.ws;
    const bf16* Z = (const bf16*)(ws + WS_Z);
    bf16* MIX = (bf16*)(ws + WS_XB);
    const int gt = blockIdx.x * 512 + opaque_tid(), NT = gridDim.x * 512;
    for (int task = gt; task < M * 16; task += NT) {
        const int q = task & 3, hh = (task >> 2) & 3; const size_t tok = (size_t)(task >> 4);
        const f32x4* ob = (const f32x4*)((const float*)((const unsigned char*)Z + tok * (size_t)(ZP * 2) + 1024) + hh * 64 + q * 16);
        f32x4 v[4]; float ss = 0.f;
#pragma unroll
        for (int k = 0; k < 4; ++k) { v[k] = ob[k]; ss += (v[k][0] * v[k][0] + v[k][1] * v[k][1]) + (v[k][2] * v[k][2] + v[k][3] * v[k][3]); }
        ss = quad_sum(ss);
        const float rs = rsqrtf(ss * (1.f / 64.f) + EPS);
        const int col = 256 + hh * 64 + q * 16;
        const v4u g0 = *(const v4u*)(Z + tok * ZP + ZC_GATE + col), g1 = *(const v4u*)(Z + tok * ZP + ZC_GATE + col + 8);
        float gv[16]; UNPACK8(g0, gv, 0); UNPACK8(g1, gv, 8);
        const float* gn = a.in[11] + layer * 64 + q * 16;
        float o[16];
#pragma unroll
        for (int k = 0; k < 4; ++k)
#pragma unroll
            for (int e = 0; e < 4; ++e) o[4 * k + e] = v[k][e] * rs * gn[4 * k + e] * siluf_(gv[4 * k + e]);
        v4u w0, w1;
        w0.x = pk2(o[0], o[1]); w0.y = pk2(o[2], o[3]); w0.z = pk2(o[4], o[5]); w0.w = pk2(o[6], o[7]);
        w1.x = pk2(o[8], o[9]); w1.y = pk2(o[10], o[11]); w1.z = pk2(o[12], o[13]); w1.w = pk2(o[14], o[15]);
        *(v4u*)(MIX + tok * DM + col) = w0; *(v4u*)(MIX + tok * DM + col + 8) = w1;
    }
}

__device__ __forceinline__ void convert_p(const Args& a, int L) {
    const f32x4* src = (const f32x4*)(a.in[1] + (size_t)L * M * 256);
    v4u* dst = (v4u*)(a.ws + WS_DN);
    const int gt = blockIdx.x * 512 + opaque_tid(), NT = gridDim.x * 512;
    for (int t = gt; t < M * 256 / 8; t += NT) { const f32x4 v0 = src[2 * t], v1 = src[2 * t + 1];
        v4u w; w.x = pk2(v0[0], v0[1]); w.y = pk2(v0[2], v0[3]); w.z = pk2(v1[0], v1[1]); w.w = pk2(v1[2], v1[3]); dst[t] = w; }
}
#define XB_TMO      128
#define XB_XCNT(j)  (256  + 64 * (j))
#define XB_XSUB(j)  (1280 + 64 * (j))
#define XB_XGEN(j)  (2304 + 64 * (j))
#define XB_TOP      3328
#define XB_TOPGEN   3392
#define XCD_BAR_WORDS 3456
#define XB_SPIN_CAP (1u << 18)

__device__ __forceinline__ unsigned xb_ld(unsigned* p)              { return __hip_atomic_load(p, __ATOMIC_RELAXED, __HIP_MEMORY_SCOPE_AGENT); }
__device__ __forceinline__ unsigned xb_add(unsigned* p, unsigned v) { return __hip_atomic_fetch_add(p, v, __ATOMIC_RELAXED, __HIP_MEMORY_SCOPE_AGENT); }
__device__ __forceinline__ unsigned xb_xcc_id() { return (unsigned)__builtin_amdgcn_s_getreg((3 << 11) | 20) & 0xFu; }
#define XB_SPIN(cond, bar) do { unsigned _sp = 0; while (cond) { __builtin_amdgcn_s_sleep(1); \
    if ((++_sp & 255u) == 0u) { if (xb_ld(&(bar)[XB_TMO])) break; if (_sp > XB_SPIN_CAP) { atomicAdd(&(bar)[XB_TMO], 1u); break; } } } } while (0)

struct XcdBarrier {
    unsigned* bar; unsigned x;
    volatile LAS unsigned* st;
};

__device__ __forceinline__ XcdBarrier xcd_barrier_post(unsigned* bar, volatile LAS unsigned* st) {
    XcdBarrier b; b.bar = bar; b.x = xb_xcc_id(); b.st = st;
    if (threadIdx.x == 0) (void)xb_add(&bar[XB_XCNT(b.x)], 1u);
    return b;
}
__device__ __forceinline__ void xcd_barrier_complete(unsigned* bar, unsigned x, unsigned& nloc, unsigned& nx) {
    const unsigned G = gridDim.x * gridDim.y * gridDim.z;
    unsigned sum, cnt, mine, sp = 0u;
    for (;;) {
        sum = 0u; cnt = 0u; mine = 0u;
#pragma unroll
        for (unsigned j = 0; j < 16; ++j) { const unsigned c = xb_ld(&bar[XB_XCNT(j)]); sum += c; cnt += (c > 0u) ? 1u : 0u; mine = (j == x) ? c : mine; }
        if (sum == G) break;
        __builtin_amdgcn_s_sleep(1);
        if ((++sp & 255u) == 0u) { if (xb_ld(&bar[XB_TMO])) break; if (sp > XB_SPIN_CAP) { atomicAdd(&bar[XB_TMO], 1u); break; } }
    }
    nloc = mine > 0u ? mine : 1u; nx = cnt > 0u ? cnt : 1u;
}

__device__ __forceinline__ void xcd_barrier(const XcdBarrier& b) {
    asm volatile("s_waitcnt vmcnt(0)" ::: "memory");
    __syncthreads();
    if (threadIdx.x == 0) {
        unsigned* bar = b.bar;
        __builtin_amdgcn_s_waitcnt(0);
        unsigned nloc = b.st[0], nx = b.st[1];
        if (nloc == 0u) { xcd_barrier_complete(bar, b.x, nloc, nx); b.st[0] = nloc; b.st[1] = nx; }
        const unsigned old = xb_add(&bar[XB_XSUB(b.x)], 1u);
        const unsigned gen = old / nloc;
        if (old + 1u == (gen + 1u) * nloc) {
            __builtin_amdgcn_fence(__ATOMIC_RELEASE, "agent");
            asm volatile("s_waitcnt vmcnt(0)" ::: "memory");
            const unsigned og = xb_add(&bar[XB_TOP], 1u);
            const unsigned tg = og / nx;
            if (og + 1u == (tg + 1u) * nx) xb_add(&bar[XB_TOPGEN], 1u);
            else XB_SPIN(xb_ld(&bar[XB_TOPGEN]) == tg, bar);
            __builtin_amdgcn_fence(__ATOMIC_ACQUIRE, "agent");
            xb_add(&bar[XB_XGEN(b.x)], 1u);
            asm volatile("s_waitcnt vmcnt(0)" ::: "memory");
        } else {
            XB_SPIN(xb_ld(&bar[XB_XGEN(b.x)]) == gen, bar);
            __builtin_amdgcn_fence(__ATOMIC_ACQUIRE, "agent");
            asm volatile("s_waitcnt vmcnt(0)" ::: "memory");
        }
    }
    __syncthreads();
}

__device__ __forceinline__ void flat_barrier(unsigned* cnt, unsigned& epoch) {
    asm volatile("s_waitcnt vmcnt(0)" ::: "memory");
    __syncthreads();
    epoch += gridDim.x;
    if (threadIdx.x == 0) {
        __builtin_amdgcn_fence(__ATOMIC_RELEASE, "agent");
        asm volatile("s_waitcnt vmcnt(0)" ::: "memory");
        __hip_atomic_fetch_add(cnt, 1u, __ATOMIC_RELAXED, __HIP_MEMORY_SCOPE_AGENT);
        unsigned sp = 0;
        while (__hip_atomic_load(cnt, __ATOMIC_RELAXED, __HIP_MEMORY_SCOPE_AGENT) < epoch) { __builtin_amdgcn_s_sleep(1); if (++sp > (1u << 22)) break; }
        __builtin_amdgcn_fence(__ATOMIC_ACQUIRE, "agent");
        asm volatile("s_waitcnt vmcnt(0)" ::: "memory");
    }
    __syncthreads();
}
constexpr int NPH = 13;
__global__ void __launch_bounds__(512, 2) mega_fwd(Args a) {
    extern __shared__ __attribute__((aligned(16))) unsigned char smem[];
    lds_t lds = (lds_t)smem;
    cg::grid_group grid = cg::this_grid();
    const int tid = opaque_tid(), G = gridDim.x, bid = blockIdx.x;
    unsigned char* ws = a.ws;
    unsigned* ctl = (unsigned*)(ws + WS_CTL);
    const int lo = a.ph_lo, hi = a.ph_hi;
    volatile LAS unsigned* bst = (volatile LAS unsigned*)(lds + MISC_OFF + 64);
    if (tid < 2) bst[tid] = 0u;
    __syncthreads();
    const XcdBarrier xbar = xcd_barrier_post(ctl + CW_BAR, bst);
#define IN(k) (lo <= (k) && (k) < hi)
    unsigned fepoch = 0;
#define GBAR() do { if (BARRIER_KIND == 0) grid.sync(); else if (BARRIER_KIND == 1) flat_barrier(ctl + CW_BAR + 4096, fepoch); else xcd_barrier(xbar); } while (0)
#define SEAM(k) do { if (IN(k) && IN((k) + 1)) { if ((CG_SEAM_MASK >> (k)) & 1u) grid.sync(); else GBAR(); } } while (0)

    if (lo < 0) grid.sync();
    if (IN(0)) for (int rep = 0; rep < PROBE_REP_P0; ++rep) { p0_prologue(a, lds); convert_p(a, 0); }
    SEAM(0);
#pragma unroll 1
    for (int L = 0; L < 2; ++L) {
        const int pb = 1 + 6 * L;
        float* ssin = L == 0 ? (float*)ctl + CW_SS0 : (float*)(ws + WS_SSP + 2 * MiB);
        float* ss1 = (float*)(ws + WS_SSP + (size_t)L * MiB);
        if (IN(pb)) for (int rep = 0; rep < PROBE_REP_G1; ++rep) {
            {
                pg8::Gemm g{(const bf16*)(ws + WS_XB), (const bf16*)(ws + WS_WIN) + (size_t)L * ZP * DM, M, ZP, DM};
                pg8::StaticOrder S; S.init(M, ZP, G, bid);
                EpiZ E{(bf16*)(ws + WS_Z), ssin, (float*)(ws + WS_BA), L == 0 ? 1 : 16};
                pg8::gemm_phase<EpiZ, pg8::StaticOrder, true, true>(lds, g, S, E);
            }
            {
                pg8::Gemm g2{(const bf16*)(ws + WS_DN), (const bf16*)(ws + WS_WPLE) + (size_t)L * DM * 256, M, DM, 256};
                pg8::StaticOrder S2;
                if (G == 256) S2.init(M, DM, 128, bid >= 128 ? bid - 128 : (1 << 20)); else S2.init(M, DM, G, bid);
                EpiPlain E2{(bf16*)(ws + WS_PP), DM};
                pg8::gemm_phase<EpiPlain, pg8::StaticOrder, true, true>(lds, g2, S2, E2);
            }
        }
        SEAM(pb);
        if (IN(pb + 1)) {
            for (int rep = 0; rep < PROBE_REP_PREP; ++rep) for (int it = bid; it < 1024; it += G) dn_prep(a, L, it, lds);
        }
        SEAM(pb + 1);
        if (IN(pb + 2)) for (int rep = 0; rep < PROBE_REP_M2; ++rep) {
            if (rep) GBAR();
            if (bid < 32 && !(rep && PROBE_M2_MODE == 2)) dn_scan(a, bid & 7, bid >> 3, lds);
            if (rep && PROBE_M2_MODE == 1) continue;
            volatile LAS int* misc = (volatile LAS int*)(lds + MISC_OFF);
            __syncthreads();
            if (tid == 0) misc[0] = (int)atomicAdd(ctl + CW_CTR + 16 * L + 4 * rep, 1u);
            __syncthreads();
            for (;;) {
                const int it = misc[0];
                if (it >= 640) break;
                unsigned nxt_item = 0u;
                if (tid == 0) nxt_item = atomicAdd(ctl + CW_CTR + 16 * L + 4 * rep, 1u);
                if (it < 256) { if (!rep || (PROBE_MIX_MASK & 4)) mixer_d(a, L, it, lds); }
                else if (it < 384) { if (!rep || (PROBE_MIX_MASK & 1)) mixer_c(a, L, it - 256, lds); }
                else { if (!rep || (PROBE_MIX_MASK & 2)) mixer_a(a, L, it - 384, lds); }
                __syncthreads();
                if (tid == 0) misc[0] = (int)nxt_item;
                __syncthreads();
            }
        }
        SEAM(pb + 2);
        for (int xs = 0; xs < PROBE_EXTRA_SYNC; ++xs) GBAR();
        if (IN(pb + 3)) for (int rep = 0; rep < PROBE_REP_FIN; ++rep) { finalize_b(a, L); if (L == 0) convert_p(a, 1); }
        SEAM(pb + 3);
        if (IN(pb + 4)) for (int rep = 0; rep < PROBE_REP_G23; ++rep) {
            pg8::Gemm g{(const bf16*)(ws + WS_XB), (const bf16*)(ws + WS_WOUT) + (size_t)L * DM * DM, M, DM, DM};
            pg8::StaticOrder S; S.init(M, DM, G, bid);
            EpiRes E{L == 0 ? a.in[0] : a.out, (bf16*)(ws + WS_X1B), ss1};
            pg8::gemm_phase<EpiRes, pg8::StaticOrder, true, true>(lds, g, S, E);
        }
        SEAM(pb + 4);
        if (IN(pb + 5)) for (int rep = 0; rep < PROBE_REP_G23; ++rep) {
            pg8::Gemm g{(const bf16*)(ws + WS_X1B), (const bf16*)(ws + WS_WG) + (size_t)L * DM * DM, M, DM, DM};
            pg8::StaticOrder S; S.init(M, DM, G, bid);
            EpiOut E{(const bf16*)(ws + WS_X1B), ss1, (const bf16*)(ws + WS_PP), a.out, (bf16*)(ws + WS_XB), (float*)(ws + WS_SSP + 2 * MiB), L == 1 ? 1 : 0};
            pg8::gemm_phase<EpiOut, pg8::StaticOrder, true, true>(lds, g, S, E);
        }
        if (L == 0) SEAM(pb + 5);
    }
#undef IN
#undef SEAM
}

extern "C" void kernel_launch(void* const* d_in, const int* in_sizes, int n_in, void* d_out, int out_size, void* d_ws, size_t ws_size, hipStream_t stream) {
    static int grid = 0;
    if (grid == 0) {
        if (n_in != 23 || ws_size < WS_END) { fprintf(stderr, "kernel_launch: unexpected inputs (n_in %d, ws %zu)\n", n_in, ws_size); grid = -1; return; }
        int dev = 0, cus = 0, per_cu = 0;
        hipGetDevice(&dev);
        hipDeviceGetAttribute(&cus, hipDeviceAttributeMultiprocessorCount, dev);
        hipFuncSetAttribute((const void*)mega_fwd, hipFuncAttributeMaxDynamicSharedMemorySize, LDS_BYTES);
        hipOccupancyMaxActiveBlocksPerMultiprocessor(&per_cu, (const void*)mega_fwd, 512, LDS_BYTES);
        if (per_cu < 1) { fprintf(stderr, "kernel_launch: occupancy query says %d blocks per CU\n", per_cu); per_cu = 1; }
        (void)hipGetLastError();
        grid = cus;
        if (grid > 256) grid = 256;
    }
    if (grid < 0) return;
    hipMemsetAsync((char*)d_ws + WS_CTL, 0, CTL_BYTES, stream);
    Args a{};
    for (int i = 0; i < 23; ++i) a.in[i] = (const float*)d_in[i];
    a.out = (float*)d_out; a.ws = (unsigned char*)d_ws; a.ph_lo = 0; a.ph_hi = NPH;
    void* kargs[] = {&a};
    hipError_t e = hipLaunchCooperativeKernel((const void*)mega_fwd, dim3(grid), dim3(512), kargs, LDS_BYTES, stream);
    if (e != hipSuccess) fprintf(stderr, "cooperative launch failed: %s (grid %d)\n", hipGetErrorString(e), grid);
}
```

```cpp
#include <hip/hip_runtime.h>
#include <hip/hip_cooperative_groups.h>
#include <cstdio>
#include <cstdint>
namespace cg = cooperative_groups;
#define PROBE_REP_G1 1
#define PROBE_REP_PREP 1
#define PROBE_REP_M2 1
#define PROBE_EXTRA_SYNC 0
#define PROBE_REP_P0 1
#define PROBE_REP_FIN 1
#define PROBE_REP_G23 1
#define CG_SEAM_MASK 0x000u
#define BARRIER_KIND 2
#define PROBE_M2_MODE 0
#define PROBE_MIX_MASK 7

__device__ __forceinline__ unsigned char* opaque_ptr(unsigned char* p) { asm volatile("" : "+s"(p)); return p; }
__device__ __forceinline__ int opaque_tid() { int t = threadIdx.x; asm volatile("" : "+v"(t)); return t; }
namespace pg8 {
#define PG8_LAS __attribute__((address_space(3)))
typedef unsigned short bf16_t;
typedef short bf16x8 __attribute__((ext_vector_type(8)));
typedef float f32x4 __attribute__((ext_vector_type(4)));
typedef unsigned u32x4 __attribute__((ext_vector_type(4)));
typedef unsigned u32x2 __attribute__((ext_vector_type(2)));
constexpr int BM = 256, BK = 64, HALF = 128, HTB = HALF * BK * 2, STAGE_BYTES = 8 * HTB, NXCD = 8, WGM = 8;

__host__ __device__ __forceinline__ int lds_byte(int r, int c) { const int st = (r >> 4) * 2 + (c >> 5), rr = r & 15, cc = c & 31, ob = rr * 64 + cc * 2; return st * 1024 + (ob ^ (((ob >> 9) & 1) << 5)); }
__host__ __device__ __forceinline__ void stage_rc(int b, int& R, int& C) { const int st = b / 1024, sb = b % 1024, swz = sb ^ (((sb >> 9) & 1) << 5); R = (st >> 1) * 16 + swz / 64; C = (st & 1) * 32 + (swz % 64) / 2; }
__host__ __device__ __forceinline__ int perm32(int rho) { const int n = rho >> 4, i = rho & 15; return 8 * (i >> 2) + 4 * n + (i & 3); }

struct Unit { int pm, pn; };
struct Gemm { const bf16_t* A; const bf16_t* Bt; int M, N, K; };

struct StaticOrder {
    int nM, nN, nwg, G, c;
    __host__ __device__ void init(int M, int N, int G_, int c_) { nM = M / BM; nN = N / BM; nwg = nM * nN; G = G_; c = c_; }
    __host__ __device__ bool next(int i, Unit& u) const {
        const long L = (long)i * G + c; if (L >= nwg) return false;
        int wgid = (int)L; { const int q = nwg / NXCD, r = nwg % NXCD, xcd = wgid % NXCD, off = wgid / NXCD; wgid = (xcd < r ? xcd * (q + 1) : r * (q + 1) + (xcd - r) * q) + off; }
        const int nig = WGM * nN, gid = wgid / nig, fm = gid * WGM, gsz = (nM - fm) < WGM ? (nM - fm) : WGM;
        u.pm = fm + ((wgid % nig) % gsz); u.pn = (wgid % nig) / gsz; return true;
    }
    __device__ __forceinline__ void a_ready(const Unit&) const {}
    __device__ __forceinline__ void done(const Unit&) const {}
};
struct PPOrder {
    int c, G;
    __device__ bool next(int i, Unit& u) const {
        int L;
        if (G == 256) { if (c < 128 || i >= 2) return false; L = (c - 128) * 2 + i; }
        else { L = i * G + c; if (L >= 256) return false; }
        u.pm = L >> 2; u.pn = L & 3; return true;
    }
    __device__ __forceinline__ void a_ready(const Unit&) const {}
    __device__ __forceinline__ void done(const Unit&) const {}
};

__device__ __forceinline__ unsigned cvt_pk_bf16(float lo, float hi) { unsigned r; asm volatile("v_cvt_pk_bf16_f32 %0, %1, %2" : "=v"(r) : "v"(lo), "v"(hi)); return r; }

template <class Epi, class Sched, bool ALIGN_EPI = false, bool SP2 = false>
__device__ __forceinline__ void gemm_phase(PG8_LAS unsigned char* lds, const Gemm g, const Sched& S, const Epi& E) {
    const int tid = opaque_tid(), wid = __builtin_amdgcn_readfirstlane(tid >> 6), lane = tid & 63, wr = wid >> 2, wc = wid & 3, fr = lane & 15, fq = lane >> 4;
    const int K = g.K, nt = K / BK;
    unsigned voffA[2], voffB[2];
#pragma unroll
    for (int i = 0; i < 2; ++i) { int R, C; stage_rc(tid * 16 + i * 8192, R, C); const int Rb = Epi::PERM ? ((R & ~31) + perm32(R & 31)) : R;
        voffA[i] = (unsigned)(R * K + C) * 2u; voffB[i] = (unsigned)(Rb * K + C) * 2u; }
    const size_t kstep = (size_t)(BK * 2);
    const size_t hstep = (size_t)HALF * K * 2;
    const size_t tstep = 2 * hstep;
    const unsigned ldsw = (unsigned)wid * 1024u;
    const int aoff = lds_byte(wr * 64 + fr, fq * 8), boff = lds_byte(wc * 32 + fr, fq * 8);
#define PG8_SA(b, h) (((b) * 2 + (h)) * HTB)
#define PG8_SB(b, h) ((4 + (b) * 2 + (h)) * HTB)
#define PG8_STAGE(bufoff, gbase, voff) do { _Pragma("unroll") for (int _i = 0; _i < 2; ++_i) \
        __builtin_amdgcn_global_load_lds((const unsigned*)((const char*)(gbase) + (voff)[_i]), (PG8_LAS unsigned*)(lds + (bufoff) + ldsw + _i * 8192), 16, 0, 0); } while (0)
#define PG8_LDA(dst, b, h) do { _Pragma("unroll") for (int m = 0; m < 4; ++m) _Pragma("unroll") for (int k = 0; k < 2; ++k) dst[m][k] = *(const PG8_LAS bf16x8*)(lds + PG8_SA(b, h) + aoff + m * 2048 + k * 1024); } while (0)
#define PG8_LDB(dst, b, h) do { _Pragma("unroll") for (int n = 0; n < 2; ++n) _Pragma("unroll") for (int k = 0; k < 2; ++k) dst[n][k] = *(const PG8_LAS bf16x8*)(lds + PG8_SB(b, h) + boff + n * 2048 + k * 1024); } while (0)
#define PG8_MMA(ai, bj, At, Bt) do { __builtin_amdgcn_s_setprio(1); _Pragma("unroll") for (int m = 0; m < 4; ++m) _Pragma("unroll") for (int n = 0; n < 2; ++n) _Pragma("unroll") for (int k = 0; k < 2; ++k) \
        acc[ai][bj][m][n] = __builtin_amdgcn_mfma_f32_16x16x32_bf16(Bt[n][k], At[m][k], acc[ai][bj][m][n], 0, 0, 0); __builtin_amdgcn_s_setprio(0); } while (0)
#define PG8_WAIT_V(n) asm volatile("s_waitcnt vmcnt(" #n ")" ::: "memory")
#define PG8_WAIT_L(n) asm volatile("s_waitcnt lgkmcnt(" #n ")" ::: "memory")
#define PG8_BAR __builtin_amdgcn_s_barrier()
#define PG8_SCHED __builtin_amdgcn_sched_barrier(0)
    Unit cur, nxt; int ui = 0;
    if (!S.next(0, cur)) return;
    f32x4 acc[2][2][4][2];
#pragma unroll
    for (int a = 0; a < 2; ++a)
#pragma unroll
        for (int b = 0; b < 2; ++b)
#pragma unroll
            for (int m = 0; m < 4; ++m)
#pragma unroll
                for (int n = 0; n < 2; ++n) acc[a][b][m][n] = (f32x4){0.f, 0.f, 0.f, 0.f};
    bf16x8 At[4][2], B0[2][2], B1[2][2];
    const char* cA = (const char*)g.A + (size_t)cur.pm * tstep; const char* cB = (const char*)g.Bt + (size_t)cur.pn * tstep;
    S.a_ready(cur);
    if constexpr (SP2) {
        PG8_STAGE(PG8_SB(0, 0), cB, voffB); PG8_STAGE(PG8_SB(0, 1), cB + hstep, voffB); PG8_STAGE(PG8_SA(0, 0), cA, voffA); PG8_STAGE(PG8_SA(0, 1), cA + hstep, voffA);
        if (wr == 1) PG8_BAR;
        PG8_WAIT_V(2); PG8_BAR;
        PG8_STAGE(PG8_SB(1, 0), cB + kstep, voffB); PG8_STAGE(PG8_SA(1, 0), cA + kstep, voffA); PG8_STAGE(PG8_SB(1, 1), cB + hstep + kstep, voffB);
        PG8_WAIT_V(6); PG8_BAR;
    } else {
        PG8_STAGE(PG8_SB(0, 0), cB, voffB); PG8_STAGE(PG8_SA(0, 0), cA, voffA); PG8_STAGE(PG8_SB(0, 1), cB + hstep, voffB); PG8_STAGE(PG8_SA(0, 1), cA + hstep, voffA);
        if (wr == 1) PG8_BAR;
        PG8_WAIT_V(4); PG8_BAR;
        PG8_STAGE(PG8_SB(1, 0), cB + kstep, voffB); PG8_STAGE(PG8_SA(1, 0), cA + kstep, voffA); PG8_STAGE(PG8_SB(1, 1), cB + hstep + kstep, voffB);
        PG8_WAIT_V(6); PG8_BAR;
    }
    for (;;) {
        const bool has_next = S.next(ui + 1, nxt);
        const char* nA = has_next ? (const char*)g.A + (size_t)nxt.pm * tstep : cA; const char* nB = has_next ? (const char*)g.Bt + (size_t)nxt.pn * tstep : cB;
#pragma unroll 1
        for (int t = 0; t < nt; t += 2) {
            const bool last = (t == nt - 2);
            const char* a1 = cA + (size_t)(t + 1) * kstep;
            const char* a2 = last ? nA : cA + (size_t)(t + 2) * kstep; const char* b2 = last ? nB : cB + (size_t)(t + 2) * kstep;
            const char* a3 = a2 + kstep; const char* b3 = b2 + kstep;
            if (last && has_next) S.a_ready(nxt);
            if constexpr (SP2) {
            PG8_LDB(B0, 0, 0); PG8_LDB(B1, 0, 1); PG8_SCHED; PG8_LDA(At, 0, 0); PG8_STAGE(PG8_SA(1, 1), a1 + hstep, voffA);
            PG8_WAIT_V(8); PG8_WAIT_L(0); PG8_BAR; PG8_MMA(0, 0, At, B0); PG8_MMA(0, 1, At, B1); PG8_BAR; PG8_SCHED;
            PG8_LDA(At, 0, 1); PG8_STAGE(PG8_SB(0, 0), b2, voffB); PG8_STAGE(PG8_SB(0, 1), b2 + hstep, voffB); PG8_STAGE(PG8_SA(0, 0), a2, voffA);
            PG8_WAIT_V(8); PG8_WAIT_L(0); PG8_BAR; PG8_MMA(1, 0, At, B0); PG8_MMA(1, 1, At, B1); PG8_BAR; PG8_SCHED;
            PG8_LDB(B0, 1, 0); PG8_LDB(B1, 1, 1); PG8_SCHED; PG8_LDA(At, 1, 0); PG8_STAGE(PG8_SA(0, 1), a2 + hstep, voffA);
            PG8_WAIT_V(8); PG8_WAIT_L(0); PG8_BAR; PG8_MMA(0, 0, At, B0); PG8_MMA(0, 1, At, B1); PG8_BAR; PG8_SCHED;
            PG8_LDA(At, 1, 1); PG8_STAGE(PG8_SB(1, 0), b3, voffB); PG8_STAGE(PG8_SB(1, 1), b3 + hstep, voffB); PG8_STAGE(PG8_SA(1, 0), a3, voffA);
            PG8_WAIT_V(8); PG8_WAIT_L(0); PG8_BAR; PG8_MMA(1, 0, At, B0); PG8_MMA(1, 1, At, B1); PG8_BAR; PG8_SCHED;
            } else {
            PG8_LDB(B0, 0, 0); PG8_SCHED; PG8_LDA(At, 0, 0); PG8_STAGE(PG8_SA(1, 1), a1 + hstep, voffA);
            PG8_WAIT_L(8); PG8_BAR; PG8_WAIT_L(0); PG8_MMA(0, 0, At, B0); PG8_BAR; PG8_SCHED;
            PG8_LDB(B1, 0, 1); PG8_STAGE(PG8_SB(0, 0), b2, voffB);
            PG8_BAR; PG8_WAIT_L(0); PG8_MMA(0, 1, At, B1); PG8_BAR;
            PG8_LDA(At, 0, 1); PG8_STAGE(PG8_SA(0, 0), a2, voffA);
            PG8_BAR; PG8_WAIT_L(0); PG8_MMA(1, 0, At, B0); PG8_BAR; PG8_SCHED;
            PG8_STAGE(PG8_SB(0, 1), b2 + hstep, voffB);
            PG8_WAIT_V(6); PG8_BAR; PG8_MMA(1, 1, At, B1); PG8_BAR;
            PG8_LDB(B0, 1, 0); PG8_SCHED; PG8_LDA(At, 1, 0); PG8_STAGE(PG8_SA(0, 1), a2 + hstep, voffA);
            PG8_WAIT_L(8); PG8_BAR; PG8_WAIT_L(0); PG8_MMA(0, 0, At, B0); PG8_BAR; PG8_SCHED;
            PG8_LDB(B1, 1, 1); PG8_STAGE(PG8_SB(1, 0), b3, voffB);
            PG8_BAR; PG8_WAIT_L(0); PG8_MMA(0, 1, At, B1); PG8_BAR;
            PG8_LDA(At, 1, 1); PG8_STAGE(PG8_SA(1, 0), a3, voffA);
            PG8_BAR; PG8_WAIT_L(0); PG8_MMA(1, 0, At, B0); PG8_BAR; PG8_SCHED;
            PG8_STAGE(PG8_SB(1, 1), b3 + hstep, voffB);
            PG8_WAIT_V(6); PG8_BAR; PG8_MMA(1, 1, At, B1); PG8_BAR;
            }
        }
        if constexpr (ALIGN_EPI) { if (wr == 0) PG8_BAR; }
        E(acc, cur, wr, wc, fr, fq); S.done(cur);
        if (!has_next) break;
#pragma unroll
        for (int a = 0; a < 2; ++a)
#pragma unroll
            for (int b = 0; b < 2; ++b)
#pragma unroll
                for (int m = 0; m < 4; ++m)
#pragma unroll
                    for (int n = 0; n < 2; ++n) acc[a][b][m][n] = (f32x4){0.f, 0.f, 0.f, 0.f};
        cur = nxt; cA = nA; cB = nB; ++ui;
        if constexpr (ALIGN_EPI) { if (wr == 1) PG8_BAR; }
    }
    PG8_WAIT_V(0);
    if constexpr (!ALIGN_EPI) { if (wr == 0) PG8_BAR; }
    PG8_BAR;
#undef PG8_SA
#undef PG8_SB
#undef PG8_STAGE
#undef PG8_LDA
#undef PG8_LDB
#undef PG8_MMA
#undef PG8_WAIT_V
#undef PG8_WAIT_L
#undef PG8_BAR
#undef PG8_SCHED
}
}

#define LAS __attribute__((address_space(3)))
typedef unsigned short bf16;
typedef unsigned v4u __attribute__((ext_vector_type(4)));
typedef unsigned v2u __attribute__((ext_vector_type(2)));
typedef float f32x4 __attribute__((ext_vector_type(4)));
typedef short bf16x8 __attribute__((ext_vector_type(8)));
typedef LAS unsigned char* lds_t;

constexpr int M = 16384, SEQ = 8192, DM = 1024, ZP = 3584, NIN = 3336;
constexpr float EPS = 1e-6f;
constexpr int ZC_GATE = 2304;
constexpr size_t MiB = 1u << 20;
constexpr size_t WS_CTL = 0, CTL_BYTES = 1 * MiB;
constexpr size_t WS_WIN = 1 * MiB;
constexpr size_t WS_WOUT = 15 * MiB;
constexpr size_t WS_WG = 19 * MiB;
constexpr size_t WS_WPLE = 23 * MiB;
constexpr size_t WS_CWS = 24 * MiB;
constexpr size_t WS_ROPE = 25 * MiB;
constexpr size_t WS_BA = 27 * MiB;
constexpr size_t WS_CDEC = 27 * MiB + 512 * 1024;
constexpr size_t WS_XB = 28 * MiB;
constexpr size_t WS_Z = 60 * MiB;
constexpr size_t WS_X1 = 60 * MiB, WS_X1B = 124 * MiB;
constexpr size_t WS_PP = 172 * MiB;
constexpr size_t WS_DN = 204 * MiB;
constexpr size_t WS_SSP = 252 * MiB;
constexpr size_t WS_END = 255 * MiB;
constexpr int CW_CTR = 0;
constexpr int CW_BAR = 131072;
constexpr int CW_SS0 = 1024, CW_SS1 = 1024 + 16384, CW_SS2 = 1024 + 3 * 16384;
constexpr int LDS_BYTES = 157696, MISC_OFF = 157440;
constexpr int DN_ITEM = 49152;

struct Args { const float* in[23]; float* out; unsigned char* ws; int ph_lo, ph_hi; };

typedef float f32x2_t __attribute__((ext_vector_type(2))); typedef __bf16 bf16x2_t __attribute__((ext_vector_type(2)));
__device__ __forceinline__ unsigned pk2(float lo, float hi) { f32x2_t v = {lo, hi}; bf16x2_t b = __builtin_convertvector(v, bf16x2_t); return __builtin_bit_cast(unsigned, b); }
__device__ __forceinline__ unsigned f2bf(float f) { return pk2(f, 0.f) & 0xffffu; }
__device__ __forceinline__ float bflo(unsigned w) { return __uint_as_float(w << 16); }
__device__ __forceinline__ float bfhi(unsigned w) { return __uint_as_float(w & 0xffff0000u); }
__device__ __forceinline__ float sigmoidf_(float x) { return __builtin_amdgcn_rcpf(1.f + __expf(-x)); }
__device__ __forceinline__ float siluf_(float x) { return x * __builtin_amdgcn_rcpf(1.f + __expf(-x)); }
__device__ __forceinline__ float geluf_(float x) { const float u = 0.7978845608028654f * (x + 0.044715f * x * x * x); return x * __builtin_amdgcn_rcpf(1.f + __expf(-2.f * u)); }
__device__ __forceinline__ float quad_sum(float v) {
    v += __int_as_float(__builtin_amdgcn_update_dpp(0, __float_as_int(v), 0xB1, 0xF, 0xF, true));
    v += __int_as_float(__builtin_amdgcn_update_dpp(0, __float_as_int(v), 0x4E, 0xF, 0xF, true));
    return v;
}
__device__ __forceinline__ float wave_sum_dpp(float v) {
    v += __int_as_float(__builtin_amdgcn_update_dpp(0, __float_as_int(v), 0xB1, 0xF, 0xF, true));
    v += __int_as_float(__builtin_amdgcn_update_dpp(0, __float_as_int(v), 0x4E, 0xF, 0xF, true));
    v += __int_as_float(__builtin_amdgcn_update_dpp(0, __float_as_int(v), 0x141, 0xF, 0xF, true));
    v += __int_as_float(__builtin_amdgcn_update_dpp(0, __float_as_int(v), 0x140, 0xF, 0xF, true));
    const int iv = __float_as_int(v);
    return (__int_as_float(__builtin_amdgcn_readlane(iv, 0)) + __int_as_float(__builtin_amdgcn_readlane(iv, 16))) +
           (__int_as_float(__builtin_amdgcn_readlane(iv, 32)) + __int_as_float(__builtin_amdgcn_readlane(iv, 48)));
}
__device__ __forceinline__ float wave_sum(float v) {
#pragma unroll
    for (int o = 1; o < 64; o <<= 1) v += __shfl_xor(v, o);
    return v;
}
__device__ __forceinline__ bf16x8 pack8(f32x4 lo, f32x4 hi) {
    v4u w; w.x = pk2(lo[0], lo[1]); w.y = pk2(lo[2], lo[3]); w.z = pk2(hi[0], hi[1]); w.w = pk2(hi[2], hi[3]);
    return __builtin_bit_cast(bf16x8, w);
}
#define UNPACK8(VV, dst, o) do { (dst)[(o) + 0] = bflo((VV)[0]); (dst)[(o) + 1] = bfhi((VV)[0]); (dst)[(o) + 2] = bflo((VV)[1]); (dst)[(o) + 3] = bfhi((VV)[1]); \
    (dst)[(o) + 4] = bflo((VV)[2]); (dst)[(o) + 5] = bfhi((VV)[2]); (dst)[(o) + 6] = bflo((VV)[3]); (dst)[(o) + 7] = bfhi((VV)[3]); } while (0)
#define LDS_WAIT() asm volatile("s_waitcnt lgkmcnt(0)" ::: "memory")
__device__ __forceinline__ int frag_off_perm(int m, int k) {
    return ((((m >> 4) * 2 + (k >> 5)) * 64 + (((k >> 2) & 3) * 16 + (m & 15))) * 8) + ((k >> 4) & 1) * 4 + (k & 3);
}
__device__ __forceinline__ int u_off(int i, int e) { return (e >> 4) * 1024 + (i >> 4) * 256 + (((i >> 2) & 3) * 16 + (e & 15)) * 4 + (i & 3); }

__device__ __forceinline__ float sum16(const float* p) {
    const f32x4 a = *(const f32x4*)p, b = *(const f32x4*)(p + 4), c = *(const f32x4*)(p + 8), d = *(const f32x4*)(p + 12);
    return ((a[0] + a[1]) + (a[2] + a[3])) + ((b[0] + b[1]) + (b[2] + b[3])) + ((c[0] + c[1]) + (c[2] + c[3])) + ((d[0] + d[1]) + (d[2] + d[3]));
}
struct EpiZ {
    static constexpr bool PERM = true;
    bf16* Z; const float* ss; float* BA; int parts;
    __device__ __forceinline__ void operator()(const f32x4 (&acc)[2][2][4][2], const pg8::Unit& u, int wr, int wc, int fr, int fq) const {
        const int row0 = u.pm * 256 + wr * 64 + fr, col0 = u.pn * 256 + wc * 32 + 8 * fq;
        const bool ba = (u.pn == 13) && (wc == 0) && (fq == 0);
#pragma unroll
        for (int ai = 0; ai < 2; ++ai)
#pragma unroll
            for (int m = 0; m < 4; ++m) {
                const int row = row0 + ai * 128 + m * 16;
                const float rs = rsqrtf((parts == 1 ? ss[row] : sum16(ss + (size_t)row * 16)) * (1.f / 1024.f) + EPS);
                bf16* rowp = Z + (size_t)row * ZP + col0;
#pragma unroll
                for (int bj = 0; bj < 2; ++bj) {
                    const f32x4 v0 = acc[ai][bj][m][0] * rs, v1 = acc[ai][bj][m][1] * rs;
                    v4u w; w.x = pg8::cvt_pk_bf16(v0[0], v0[1]); w.y = pg8::cvt_pk_bf16(v0[2], v0[3]); w.z = pg8::cvt_pk_bf16(v1[0], v1[1]); w.w = pg8::cvt_pk_bf16(v1[2], v1[3]);
                    if (u.pn != 13) *(v4u*)(rowp + bj * 128) = w;
                    if (bj == 0 && ba) { *(f32x4*)(BA + (size_t)row * 8) = v0; *(f32x4*)(BA + (size_t)row * 8 + 4) = v1; }
                }
            }
    }
};
struct EpiPlain {
    static constexpr bool PERM = true;
    bf16* O; int ldc;
    __device__ __forceinline__ void operator()(const f32x4 (&acc)[2][2][4][2], const pg8::Unit& u, int wr, int wc, int fr, int fq) const {
        const int row0 = u.pm * 256 + wr * 64 + fr, col0 = u.pn * 256 + wc * 32 + 8 * fq;
#pragma unroll
        for (int ai = 0; ai < 2; ++ai)
#pragma unroll
            for (int m = 0; m < 4; ++m) {
                bf16* rowp = O + (size_t)(row0 + ai * 128 + m * 16) * ldc + col0;
#pragma unroll
                for (int bj = 0; bj < 2; ++bj) {
                    const f32x4 v0 = acc[ai][bj][m][0], v1 = acc[ai][bj][m][1];
                    v4u w; w.x = pg8::cvt_pk_bf16(v0[0], v0[1]); w.y = pg8::cvt_pk_bf16(v0[2], v0[3]); w.z = pg8::cvt_pk_bf16(v1[0], v1[1]); w.w = pg8::cvt_pk_bf16(v1[2], v1[3]);
                    *(v4u*)(rowp + bj * 128) = w;
                }
            }
    }
};
struct EpiRes {
    static constexpr bool PERM = true;
    const float* xin; bf16* x1b; float* ss;
    __device__ __forceinline__ void operator()(const f32x4 (&acc)[2][2][4][2], const pg8::Unit& u, int wr, int wc, int fr, int fq) const {
        const int col0 = u.pn * 256 + wc * 32 + 8 * fq;
#pragma unroll
        for (int aim = 0; aim < 4; ++aim) {
            const int ai = aim >> 1, m0 = (aim & 1) * 2;
            f32x4 r[4][2][2];
#pragma unroll
            for (int m = m0; m < m0 + 2; ++m)
#pragma unroll
                for (int bj = 0; bj < 2; ++bj)
#pragma unroll
                    for (int n = 0; n < 2; ++n) r[m][bj][n] = *(const f32x4*)(xin + (size_t)(u.pm * 256 + ai * 128 + wr * 64 + m * 16 + fr) * DM + col0 + bj * 128 + 4 * n);
#pragma unroll
            for (int m = m0; m < m0 + 2; ++m) {
                const int row = u.pm * 256 + ai * 128 + wr * 64 + m * 16 + fr;
                float s = 0.f;
#pragma unroll
                for (int bj = 0; bj < 2; ++bj) {
                    const size_t off = (size_t)row * DM + col0 + bj * 128;
                    const f32x4 v0 = r[m][bj][0] + acc[ai][bj][m][0], v1 = r[m][bj][1] + acc[ai][bj][m][1];
                    v4u w; w.x = pg8::cvt_pk_bf16(v0[0], v0[1]); w.y = pg8::cvt_pk_bf16(v0[2], v0[3]); w.z = pg8::cvt_pk_bf16(v1[0], v1[1]); w.w = pg8::cvt_pk_bf16(v1[2], v1[3]);
                    *(v4u*)(x1b + off) = w;
                    s += ((v0[0] * v0[0] + v0[1] * v0[1]) + (v0[2] * v0[2] + v0[3] * v0[3])) + ((v1[0] * v1[0] + v1[1] * v1[1]) + (v1[2] * v1[2] + v1[3] * v1[3]));
                }
                s += __shfl_xor(s, 16); s += __shfl_xor(s, 32);
                if (fq == 0) ss[(size_t)row * 16 + u.pn * 4 + wc] = s;
            }
            asm volatile("" ::: "memory");
        }
    }
};
struct EpiOut {
    static constexpr bool PERM = true;
    const bf16* x1; const float* ss1; const bf16* pp; float* out; bf16* xb; float* ss2; int last;
    __device__ __forceinline__ void operator()(const f32x4 (&acc)[2][2][4][2], const pg8::Unit& u, int wr, int wc, int fr, int fq) const {
        const int col0 = u.pn * 256 + wc * 32 + 8 * fq;
#pragma unroll
        for (int aim = 0; aim < 4; ++aim) {
            const int ai = aim >> 1, m0 = (aim & 1) * 2;
            v4u xw[4][2], pw[4][2]; f32x4 pt[4]; float rsv[4];
#pragma unroll
            for (int m = m0; m < m0 + 2; ++m) pt[m] = *(const f32x4*)(ss1 + (size_t)(u.pm * 256 + ai * 128 + wr * 64 + m * 16 + fr) * 16 + 4 * fq);
#pragma unroll
            for (int m = m0; m < m0 + 2; ++m)
#pragma unroll
                for (int bj = 0; bj < 2; ++bj) { const size_t off = (size_t)(u.pm * 256 + ai * 128 + wr * 64 + m * 16 + fr) * DM + col0 + bj * 128;
                    xw[m][bj] = *(const v4u*)(x1 + off); pw[m][bj] = *(const v4u*)(pp + off); }
#pragma unroll
            for (int m = m0; m < m0 + 2; ++m) { float t = (pt[m][0] + pt[m][1]) + (pt[m][2] + pt[m][3]); t += __shfl_xor(t, 16); t += __shfl_xor(t, 32); rsv[m] = rsqrtf(t * (1.f / 1024.f) + EPS); }
#pragma unroll
            for (int m = m0; m < m0 + 2; ++m) {
                const int row = u.pm * 256 + ai * 128 + wr * 64 + m * 16 + fr;
                const float rs = rsv[m];
                float s = 0.f;
#pragma unroll
                for (int bj = 0; bj < 2; ++bj) {
                    const size_t off = (size_t)row * DM + col0 + bj * 128;
                    const v4u x_ = xw[m][bj], p_ = pw[m][bj];
                    const f32x4 a0 = acc[ai][bj][m][0] * rs, a1 = acc[ai][bj][m][1] * rs;
                    f32x4 v0, v1;
                    v0[0] = bflo(x_.x) + sigmoidf_(a0[0]) * bflo(p_.x); v0[1] = bfhi(x_.x) + sigmoidf_(a0[1]) * bfhi(p_.x);
                    v0[2] = bflo(x_.y) + sigmoidf_(a0[2]) * bflo(p_.y); v0[3] = bfhi(x_.y) + sigmoidf_(a0[3]) * bfhi(p_.y);
                    v1[0] = bflo(x_.z) + sigmoidf_(a1[0]) * bflo(p_.z); v1[1] = bfhi(x_.z) + sigmoidf_(a1[1]) * bfhi(p_.z);
                    v1[2] = bflo(x_.w) + sigmoidf_(a1[2]) * bflo(p_.w); v1[3] = bfhi(x_.w) + sigmoidf_(a1[3]) * bfhi(p_.w);
                    if (last) { __builtin_nontemporal_store(v0, (f32x4*)(out + off)); __builtin_nontemporal_store(v1, (f32x4*)(out + off + 4)); }
                    else { *(f32x4*)(out + off) = v0; *(f32x4*)(out + off + 4) = v1; }
                    if (!last) { v4u w; w.x = pg8::cvt_pk_bf16(v0[0], v0[1]); w.y = pg8::cvt_pk_bf16(v0[2], v0[3]); w.z = pg8::cvt_pk_bf16(v1[0], v1[1]); w.w = pg8::cvt_pk_bf16(v1[2], v1[3]);
                        *(v4u*)(xb + off) = w;
                        s += ((v0[0] * v0[0] + v0[1] * v0[1]) + (v0[2] * v0[2] + v0[3] * v0[3])) + ((v1[0] * v1[0] + v1[1] * v1[1]) + (v1[2] * v1[2] + v1[3] * v1[3])); }
                }
                if (!last) { s += __shfl_xor(s, 16); s += __shfl_xor(s, 32); if (fq == 0) ss2[(size_t)row * 16 + u.pn * 4 + wc] = s; }
            }
            asm volatile("" ::: "memory");
        }
    }
};

template <int MODE, bool HAS_SCALE>
__device__ __forceinline__ void transpose_item(const float* W, int K, int Nsrc, bf16* WT, const float* kscale, LAS float* scr, int item, int nblk, int lane) {
    const int kb = item / nblk, nb = item % nblk, k0 = 64 * kb, n0 = 32 * nb;
    const int n = n0 + (lane & 31);
    int sc = n; bool ok = true;
    if (MODE == 1) { sc = n < 1280 ? n : (n < 3328 ? n + 8 : n - 2048); ok = n < NIN; }
    const float okf = ok ? 1.f : 0.f; const int scc = ok ? sc : 0;
#pragma unroll 16
    for (int i = 0; i < 32; ++i) { const int kk = 2 * i + (lane >> 5); float v = W[(size_t)(k0 + kk) * Nsrc + scc] * okf; if (HAS_SCALE) v *= kscale[k0 + kk]; scr[kk * 33 + (lane & 31)] = v; }
    LDS_WAIT(); asm volatile("" ::: "memory");
    const int c = lane & 7;
#pragma unroll
    for (int j = 0; j < 4; ++j) { const int nn = (lane >> 3) + 8 * j; const LAS float* s = scr + (8 * c) * 33 + nn;
        v4u o; o.x = pk2(s[0 * 33], s[1 * 33]); o.y = pk2(s[2 * 33], s[3 * 33]); o.z = pk2(s[4 * 33], s[5 * 33]); o.w = pk2(s[6 * 33], s[7 * 33]);
        *(v4u*)(WT + (size_t)(n0 + nn) * K + k0 + 8 * c) = o; }
    LDS_WAIT(); asm volatile("" ::: "memory");
}
__device__ __forceinline__ void sincos_d(double a, float& s, float& c) {
    const double TWO_PI = 6.283185307179586476925;
    const double k = rint(a / TWO_PI); const double r = a - k * TWO_PI;
    const double h = 0.5 * r, h2 = h * h;
    const double sh = h * (1.0 + h2 * (-1.0 / 6.0 + h2 * (1.0 / 120.0 + h2 * (-1.0 / 5040.0 + h2 * (1.0 / 362880.0 + h2 * (-1.0 / 39916800.0 + h2 * (1.0 / 6227020800.0 + h2 * (-1.0 / 1307674368000.0 + h2 * (1.0 / 355687428096000.0 + h2 * (-1.0 / 121645100408832000.0))))))))));
    const double ch = 1.0 + h2 * (-0.5 + h2 * (1.0 / 24.0 + h2 * (-1.0 / 720.0 + h2 * (1.0 / 40320.0 + h2 * (-1.0 / 3628800.0 + h2 * (1.0 / 479001600.0 + h2 * (-1.0 / 87178291200.0 + h2 * (1.0 / 20922789888000.0 + h2 * (-1.0 / 6402373705728000.0 + h2 * (1.0 / 2432902008176640000.0))))))))));
    s = (float)(2.0 * sh * ch); c = (float)(1.0 - 2.0 * sh * sh);
}
__device__ __forceinline__ void p0_prologue(const Args& a, lds_t lds) {
    const int tid = opaque_tid(), lane = tid & 63, wave = tid >> 6, G = gridDim.x;
    unsigned char* ws = a.ws;
    LAS float* scr = (LAS float*)(lds + wave * 16384);
    const int gw = blockIdx.x * 8 + wave, NGW = G * 8;
    constexpr int I_IN = 16 * 112, I_OUT = 16 * 32, I_G = 16 * 32, I_PLE = 4 * 32, I_L = I_IN + I_OUT + I_G + I_PLE;
    for (int it = gw; it < 2 * I_L; it += NGW) {
        const int L = it / I_L; int r = it % I_L;
        if (r < I_IN) { transpose_item<1, true>(a.in[3] + (size_t)L * DM * NIN, DM, NIN, (bf16*)(ws + WS_WIN) + (size_t)L * ZP * DM, a.in[2] + L * DM, scr, r, 112, lane); continue; } r -= I_IN;
        if (r < I_OUT) { transpose_item<0, false>(a.in[4] + (size_t)L * DM * DM, DM, DM, (bf16*)(ws + WS_WOUT) + (size_t)L * DM * DM, nullptr, scr, r, 32, lane); continue; } r -= I_OUT;
        if (r < I_G) { transpose_item<0, true>(a.in[22] + (size_t)L * DM * DM, DM, DM, (bf16*)(ws + WS_WG) + (size_t)L * DM * DM, a.in[21] + L * DM, scr, r, 32, lane); continue; } r -= I_G;
        transpose_item<0, false>(a.in[20] + (size_t)L * 256 * DM, 256, DM, (bf16*)(ws + WS_WPLE) + (size_t)L * DM * 256, nullptr, scr, r, 32, lane);
    }
    float* ss0 = (float*)(ws + WS_CTL) + CW_SS0;
    for (int m = gw; m < M; m += 2 * NGW) {
        const int m2 = m + NGW;
        const f32x4* xr = (const f32x4*)(a.in[0] + (size_t)m * DM) + lane;
        const f32x4* xr2 = (const f32x4*)(a.in[0] + (size_t)(m2 < M ? m2 : m) * DM) + lane;
        f32x4 v[4], w[4];
#pragma unroll
        for (int j = 0; j < 4; ++j) { v[j] = xr[64 * j]; w[j] = xr2[64 * j]; }
        unsigned long long* o8 = (unsigned long long*)((bf16*)(ws + WS_XB) + (size_t)m * DM) + lane;
        unsigned long long* o82 = (unsigned long long*)((bf16*)(ws + WS_XB) + (size_t)(m2 < M ? m2 : m) * DM) + lane;
        float s = 0.f, s2 = 0.f;
#pragma unroll
        for (int j = 0; j < 4; ++j) {
            s += (v[j][0] * v[j][0] + v[j][1] * v[j][1]) + (v[j][2] * v[j][2] + v[j][3] * v[j][3]);
            s2 += (w[j][0] * w[j][0] + w[j][1] * w[j][1]) + (w[j][2] * w[j][2] + w[j][3] * w[j][3]);
            o8[64 * j] = (unsigned long long)pk2(v[j][0], v[j][1]) | ((unsigned long long)pk2(v[j][2], v[j][3]) << 32);
            if (m2 < M) o82[64 * j] = (unsigned long long)pk2(w[j][0], w[j][1]) | ((unsigned long long)pk2(w[j][2], w[j][3]) << 32);
        }
        s = wave_sum(s); s2 = wave_sum(s2);
        if (lane == 0) { ss0[m] = s; if (m2 < M) ss0[m2] = s2; }
    }
    const int gt = blockIdx.x * 512 + tid, NT = G * 512;
    for (int idx = gt; idx < 2 * 4 * 128 * 128; idx += NT) { const int i = (idx >> 7) & 127, j = idx & 127; ((bf16*)(ws + WS_CWS))[idx] = (bf16)f2bf(j <= i ? a.in[14][idx] : 0.f); }
    for (int idx = gt; idx < SEQ * 32; idx += NT) { const int pos = idx >> 5, j = idx & 31;
        const float inv = (float)exp(-(double)j * (1.0 / 32.0) * 9.210340371976182736);
        const float ang = (float)pos * inv; float s, c; sincos_d((double)ang, s, c);
        ((float*)(ws + WS_ROPE))[idx] = c; ((float*)(ws + WS_ROPE + MiB))[idx] = s; }
}

__device__ __forceinline__ void dn_prep(const Args& a, int layer, int item, lds_t lds) {
    const int tid = opaque_tid(), lane = tid & 63, wave = tid >> 6;
    const int h = item & 3, cn = (item >> 2) & 127, b = item >> 9;
    const int tok0 = b * SEQ + cn * 64;
    unsigned char* ws = a.ws;
    const bf16* Z = (const bf16*)(ws + WS_Z);
    const float* BA = (const float*)(ws + WS_BA);
    LAS float* Q = (LAS float*)lds;
    LAS float* Kk = Q + 64 * 68;
    LAS float* V = Kk + 64 * 68;
    LAS float* Ar = V + 64 * 68;
    LAS float* sm = Ar + 4096;
    lds_t img = lds + 71680;
    const float bl_pre = BA[(size_t)(tok0 + lane) * 8 + h], al_pre = BA[(size_t)(tok0 + lane) * 8 + 4 + h];
#pragma unroll
    for (int j = 0; j < 8; ++j) Ar[tid + 512 * j] = 0.f;
    *(LAS v4u*)(img + 24576 + tid * 16) = (v4u){0u, 0u, 0u, 0u};
    {
        const int t = tid >> 3, cg = tid & 7;
        const float* cw = a.in[8] + (size_t)layer * 4 * 768;
#pragma unroll
        for (int r = 0; r < 3; ++r) {
            const int ch0 = r * 256 + h * 64 + cg * 8;
            float acc[8];
#pragma unroll
            for (int j = 0; j < 8; ++j) acc[j] = 0.f;
#pragma unroll
            for (int k = 0; k < 4; ++k) {
                const int row = t - 3 + k;
                const bool okr = cn * 64 + row >= 0; const float kf = okr ? 1.f : 0.f;
                {
                    const v4u w = *(const v4u*)(Z + (size_t)(tok0 + (okr ? row : 0)) * ZP + 512 + ch0);
                    float x[8]; UNPACK8(w, x, 0);
                    const f32x4 w0 = *(const f32x4*)(cw + k * 768 + ch0) * kf, w1 = *(const f32x4*)(cw + k * 768 + ch0 + 4) * kf;
                    acc[0] += w0[0] * x[0]; acc[1] += w0[1] * x[1]; acc[2] += w0[2] * x[2]; acc[3] += w0[3] * x[3];
                    acc[4] += w1[0] * x[4]; acc[5] += w1[1] * x[5]; acc[6] += w1[2] * x[6]; acc[7] += w1[3] * x[7];
                }
            }
            float ss = 0.f;
#pragma unroll
            for (int j = 0; j < 8; ++j) { acc[j] = siluf_(acc[j]); ss += acc[j] * acc[j]; }
            if (r < 2) {
                ss += __shfl_xor(ss, 1); ss += __shfl_xor(ss, 2); ss += __shfl_xor(ss, 4);
                const float sc = rsqrtf(ss + EPS) * (r == 0 ? 0.125f : 1.f);
#pragma unroll
                for (int j = 0; j < 8; ++j) acc[j] *= sc;
            }
            LAS float* dst = (r == 0 ? Q : (r == 1 ? Kk : V)) + t * 68 + cg * 8;
            *(LAS f32x4*)dst = (f32x4){acc[0], acc[1], acc[2], acc[3]};
            *(LAS f32x4*)(dst + 4) = (f32x4){acc[4], acc[5], acc[6], acc[7]};
        }
    }
    if (wave == 0) {
        const int t = lane;
        const float bl = bl_pre, al = al_pre;
        const float beta = sigmoidf_(bl);
        const float xx = al + a.in[10][layer * 4 + h];
        const float sp = xx > 20.f ? xx : log1pf(expf(xx));
        float gd = -expf(a.in[9][layer * 4 + h]) * sp;
#pragma unroll
        for (int off = 1; off < 64; off <<= 1) { const float y = __shfl_up(gd, off); if (lane >= off) gd += y; }
        const float gl = __shfl(gd, 63);
        const float eg = expf(gd);
        sm[t] = beta; sm[64 + t] = gd; sm[128 + t] = eg; sm[192 + t] = beta * eg; sm[256 + t] = expf(gl - gd);
        if (lane == 63) ((float*)(ws + WS_CDEC))[item] = eg;
    }
    __syncthreads();
    {
        const int ql = lane & 15, g = lane >> 4;
#pragma unroll
        for (int rr = 0; rr < 3; ++rr) {
            const int tk = wave + 8 * rr;
            if (tk < 20) {
                const int kind = tk / 10, idx = tk % 10;
                const int it = idx < 1 ? 0 : (idx < 3 ? 1 : (idx < 6 ? 2 : 3)), jt = idx - (it * (it + 1)) / 2;
                const LAS float* As = (kind == 0 ? Kk : Q) + (16 * it + ql) * 68 + 16 * g;
                const LAS float* Bs = Kk + (16 * jt + ql) * 68 + 16 * g;
                f32x4 av[4], bv[4];
#pragma unroll
                for (int q = 0; q < 4; ++q) { av[q] = *(const LAS f32x4*)(As + 4 * q); bv[q] = *(const LAS f32x4*)(Bs + 4 * q); }
                f32x4 acc = (f32x4){0.f, 0.f, 0.f, 0.f};
#pragma unroll
                for (int q = 0; q < 4; ++q)
#pragma unroll
                    for (int e = 0; e < 4; ++e) acc = __builtin_amdgcn_mfma_f32_16x16x4f32(av[q][e], bv[q][e], acc, 0, 0, 0);
                const int j = 16 * jt + ql; const float gcj = sm[64 + j];
#pragma unroll
                for (int e = 0; e < 4; ++e) {
                    const int i = 16 * it + 4 * g + e;
                    const float df = sm[64 + i] - gcj;
                    if (kind == 0) { const float v = (i > j) ? sm[i] * acc[e] * __expf(df) : 0.f; Ar[i * 64 + (j & 3) * 16 + (j >> 2)] = v; }
                    else { const float v = (i >= j) ? acc[e] * __expf(df) : 0.f; *(LAS bf16*)(img + 24576 + 2 * frag_off_perm(i, j)) = (bf16)f2bf(v); }
                }
            }
        }
    }
    __syncthreads();
    {
        LAS float* Xs = (LAS float*)(lds + 120832);
        LAS float* Ys = (LAS float*)(lds + 137216);
        LAS float* Ti = (LAS float*)(lds + 145408);
        if (wave < 4 && lane < 16) {
            const int bb = wave, c = lane;
            float t[16];
#pragma unroll
            for (int i = 0; i < 16; ++i) {
                float acc = (i == c) ? 1.f : 0.f;
#pragma unroll
                for (int k = 0; k < 16; ++k) if (k < i) acc -= Ar[(16 * bb + i) * 64 + (k & 3) * 16 + 4 * bb + (k >> 2)] * t[k];
                t[i] = acc;
                Ti[bb * 256 + i * 16 + (c & 3) * 4 + (c >> 2)] = acc;
            }
        }
        __syncthreads();
        {
            const int ql = lane & 15, kq = lane >> 4, w = wave;
            LAS float* Xb = (w < 4) ? (LAS float*)(img + 32768 + w * 4096) : (Xs + (w - 4) * 1024);
            LAS float* Yw = Ys + w * 256;
            const LAS float* Rsrc = (w < 4) ? (V + 16 * w + ql) : (Kk + 16 * (w - 4) + ql);
            const LAS float* Rscl = (w < 4) ? sm : (sm + 192);
#pragma unroll
            for (int bb = 0; bb < 4; ++bb) {
                f32x4 acc = (f32x4){0.f, 0.f, 0.f, 0.f};
#pragma unroll
                for (int j = 0; j < 4; ++j) if (j < bb) {
                    const f32x4 av = *(const LAS f32x4*)(Ar + (16 * bb + ql) * 64 + kq * 16 + 4 * j);
#pragma unroll
                    for (int q = 0; q < 4; ++q) acc = __builtin_amdgcn_mfma_f32_16x16x4f32(av[q], Xb[j * 256 + (q * 16 + ql) * 4 + kq], acc, 0, 0, 0);
                }
                f32x4 y;
#pragma unroll
                for (int e = 0; e < 4; ++e) { const int row = 16 * bb + 4 * kq + e; y[e] = Rsrc[row * 68] * Rscl[row] - acc[e]; }
#pragma unroll
                for (int e = 0; e < 4; ++e) Yw[(4 * kq + e) * 16 + ql] = y[e];
                LDS_WAIT(); asm volatile("" ::: "memory");
                const f32x4 tv = *(const LAS f32x4*)(Ti + bb * 256 + ql * 16 + kq * 4);
                f32x4 x = (f32x4){0.f, 0.f, 0.f, 0.f};
#pragma unroll
                for (int q = 0; q < 4; ++q) x = __builtin_amdgcn_mfma_f32_16x16x4f32(tv[q], Yw[(4 * q + kq) * 16 + ql], x, 0, 0, 0);
                *(LAS f32x4*)(Xb + bb * 256 + lane * 4) = x;
                if (w >= 4) {
#pragma unroll
                    for (int e = 0; e < 4; ++e) *(LAS bf16*)(img + 2 * frag_off_perm(16 * bb + 4 * kq + e, 16 * (w - 4) + ql)) = (bf16)f2bf(x[e]);
                }
                LDS_WAIT(); asm volatile("" ::: "memory");
            }
        }
    }
#pragma unroll
    for (int j = 0; j < 8; ++j) {
        const int idx = tid + 512 * j, i = idx >> 6, d = idx & 63;
        *(LAS bf16*)(img + 8192 + 2 * frag_off_perm(i, d)) = (bf16)f2bf(Q[i * 68 + d] * sm[128 + i]);
        *(LAS bf16*)(img + 16384 + 2 * frag_off_perm(d, i)) = (bf16)f2bf(Kk[i * 68 + d] * sm[256 + i]);
    }
    __syncthreads();
    {
        unsigned char* dst = ws + WS_DN + (size_t)item * DN_ITEM;
#pragma unroll
        for (int j = 0; j < 6; ++j) { const int p = tid + 512 * j; *(v4u*)(dst + p * 16) = *(const LAS v4u*)(img + p * 16); }
    }
    __syncthreads();
}

__device__ __forceinline__ void glds16(const void* gsrc, unsigned lds_dst) { unsigned keep; lds_dst = __builtin_amdgcn_readfirstlane(lds_dst);
    asm volatile("s_mov_b32 %0, m0\n\ts_mov_b32 m0, %2\n\ts_nop 0\n\tglobal_load_lds_dwordx4 %1, off\n\ts_mov_b32 m0, %0" : "=&s"(keep) : "v"(gsrc), "s"(lds_dst) : "memory"); }
constexpr int SCAN_SLOT = 36864, SCAN_CD_OFF = 4 * SCAN_SLOT, SCAN_HB_OFF = SCAN_CD_OFF + 512;
__device__ __forceinline__ void dn_scan(const Args& a, int bh, int slice, lds_t lds) {
    const int tid = opaque_tid(), lane = tid & 63, wave = __builtin_amdgcn_readfirstlane(tid >> 6);
    const int b = bh >> 2, h = bh & 3;
    unsigned char* ws = opaque_ptr(a.ws);
    const unsigned char* DN = ws + WS_DN;
    LAS float* cd = (LAS float*)(lds + SCAN_CD_OFF);
    if (tid < 128) cd[tid] = ((const float*)(ws + WS_CDEC))[(b * 128 + tid) * 4 + h];
    __syncthreads();
    const bool stager = wave >= 2;
    const int pc0 = (wave - 2) * 6;
    const unsigned ldsbase = (unsigned)(size_t)lds;
#define SCAN_ISSUE(n, slot) do { if (stager) { const int _n = (n) < 128 ? (n) : 127; const unsigned char* _s = DN + (size_t)((b * 128 + _n) * 4 + h) * DN_ITEM + lane * 16; \
        _Pragma("unroll") for (int _j = 0; _j < 6; ++_j) { const int _pc = pc0 + _j; const int _go = _pc < 32 ? _pc * 1024 : 32768 + slice * 4096 + (_pc - 32) * 1024; \
            glds16(_s + _go, ldsbase + (slot) * SCAN_SLOT + _pc * 1024); } } } while (0)
#define SCAN_BAR6() do { if (stager) asm volatile("s_waitcnt vmcnt(6)" ::: "memory"); asm volatile("s_waitcnt lgkmcnt(0)" ::: "memory"); __builtin_amdgcn_s_barrier(); asm volatile("" ::: "memory"); } while (0)
    SCAN_ISSUE(0, 0); SCAN_ISSUE(1, 1);
    SCAN_BAR6();
    f32x4 S[4];
#pragma unroll
    for (int t = 0; t < 4; ++t) S[t] = (f32x4){0.f, 0.f, 0.f, 0.f};
    const int g = lane >> 4, ql = lane & 15;
    float* OB = (float*)((unsigned char*)(ws + WS_Z) + 1024) + h * 64 + slice * 16 + ql;
#define MF(A, B, C) __builtin_amdgcn_mfma_f32_16x16x32_bf16(A, B, C, 0, 0, 0)
#define SCAN_W0(n, slot, hb) do { if (wave == 0) { \
        const lds_t bp = lds + (slot) * SCAN_SLOT + lane * 16; const lds_t hp = lds + SCAN_HB_OFF + (hb) * 4096 + lane * 16; \
        bf16x8 fw[8], fg[8]; f32x4 uu[4]; \
        _Pragma("unroll") for (int i = 0; i < 8; ++i) fw[i] = *(const LAS bf16x8*)(bp + i * 1024); \
        _Pragma("unroll") for (int t = 0; t < 4; ++t) uu[t] = *(const LAS f32x4*)(bp + 32768 + t * 1024); \
        _Pragma("unroll") for (int i = 0; i < 8; ++i) fg[i] = *(const LAS bf16x8*)(bp + 16384 + i * 1024); \
        const float dec = cd[(n)]; \
        const bf16x8 Sb0 = pack8(S[0], S[1]), Sb1 = pack8(S[2], S[3]); \
        *(LAS bf16x8*)(hp) = Sb0; *(LAS bf16x8*)(hp + 1024) = Sb1; \
        f32x4 vn[4]; const f32x4 zz = (f32x4){0.f, 0.f, 0.f, 0.f}; \
        _Pragma("unroll") for (int t = 0; t < 4; ++t) vn[t] = MF(fw[2 * t], Sb0, zz); \
        _Pragma("unroll") for (int t = 0; t < 4; ++t) vn[t] = uu[t] - MF(fw[2 * t + 1], Sb1, vn[t]); \
        const bf16x8 Vb0 = pack8(vn[0], vn[1]), Vb1 = pack8(vn[2], vn[3]); \
        *(LAS bf16x8*)(hp + 2048) = Vb0; *(LAS bf16x8*)(hp + 3072) = Vb1; \
        _Pragma("unroll") for (int t = 0; t < 4; ++t) S[t] = MF(fg[2 * t], Vb0, S[t] * dec); \
        _Pragma("unroll") for (int t = 0; t < 4; ++t) S[t] = MF(fg[2 * t + 1], Vb1, S[t]); \
    } } while (0)
#define SCAN_W1(n, slot, hb) do { if (wave == 1 && (n) >= 0) { \
        const lds_t bp = lds + (slot) * SCAN_SLOT + lane * 16; const lds_t hp = lds + SCAN_HB_OFF + (hb) * 4096 + lane * 16; \
        bf16x8 fq[8], fk[8]; \
        _Pragma("unroll") for (int i = 0; i < 8; ++i) fq[i] = *(const LAS bf16x8*)(bp + 8192 + i * 1024); \
        _Pragma("unroll") for (int i = 0; i < 8; ++i) fk[i] = *(const LAS bf16x8*)(bp + 24576 + i * 1024); \
        const bf16x8 Sb0 = *(const LAS bf16x8*)(hp), Sb1 = *(const LAS bf16x8*)(hp + 1024), Vb0 = *(const LAS bf16x8*)(hp + 2048), Vb1 = *(const LAS bf16x8*)(hp + 3072); \
        f32x4 oo[4]; const f32x4 zz = (f32x4){0.f, 0.f, 0.f, 0.f}; \
        _Pragma("unroll") for (int t = 0; t < 4; ++t) oo[t] = MF(fq[2 * t], Sb0, zz); \
        _Pragma("unroll") for (int t = 0; t < 4; ++t) oo[t] = MF(fq[2 * t + 1], Sb1, oo[t]); \
        _Pragma("unroll") for (int t = 0; t < 4; ++t) oo[t] = MF(fk[2 * t], Vb0, oo[t]); \
        _Pragma("unroll") for (int t = 0; t < 4; ++t) oo[t] = MF(fk[2 * t + 1], Vb1, oo[t]); \
        const size_t tokb = (size_t)b * SEQ + (size_t)(n) * 64; \
        _Pragma("unroll") for (int t = 0; t < 4; ++t) \
            _Pragma("unroll") for (int e = 0; e < 4; ++e) *(float*)((unsigned char*)OB + (tokb + 16 * t + 4 * g + e) * (size_t)(ZP * 2)) = oo[t][e]; \
    } } while (0)
#pragma unroll 1
    for (int n0 = 0; n0 < 128; n0 += 4) {
        SCAN_ISSUE(n0 + 2, 2); SCAN_W0(n0 + 0, 0, 0); SCAN_W1(n0 - 1, 3, 1); SCAN_BAR6();
        SCAN_ISSUE(n0 + 3, 3); SCAN_W0(n0 + 1, 1, 1); SCAN_W1(n0 + 0, 0, 0); SCAN_BAR6();
        SCAN_ISSUE(n0 + 4, 0); SCAN_W0(n0 + 2, 2, 0); SCAN_W1(n0 + 1, 1, 1); SCAN_BAR6();
        SCAN_ISSUE(n0 + 5, 1); SCAN_W0(n0 + 3, 3, 1); SCAN_W1(n0 + 2, 2, 0); SCAN_BAR6();
    }
    SCAN_W1(127, 3, 1);
#undef SCAN_ISSUE
#undef SCAN_W0
#undef SCAN_W1
#undef SCAN_BAR6
#undef MF
    asm volatile("s_waitcnt vmcnt(0)" ::: "memory");
    __syncthreads();
}

__device__ __forceinline__ void mixer_a(const Args& a, int layer, int item, lds_t lds) {
    const int tid = opaque_tid(), lane = tid & 63, wave = tid >> 6;
    const int kvh = item & 1, blk = (item >> 1) & 63, b = item >> 7;
    unsigned char* ws = a.ws;
    const bf16* Z = (const bf16*)(ws + WS_Z);
    bf16* MIX = (bf16*)(ws + WS_XB);
    const float* cosT = (const float*)(ws + WS_ROPE); const float* sinT = (const float*)(ws + WS_ROPE + MiB);
    const float* qgain = a.in[5] + layer * 64; const float* kgain = a.in[6] + layer * 64; const float* sink = a.in[7] + layer * 4;
    LAS bf16* Kl = (LAS bf16*)lds;
    LAS bf16* Vt = (LAS bf16*)(lds + 36864);
    v4u vw[4]; bool vvalid; int vkk, vdh;
    {
        vkk = tid & 255; vdh = tid >> 8; const int kt = blk * 128 - 128 + vkk; vvalid = kt >= 0;
        const v4u* src = (const v4u*)(Z + (size_t)(b * SEQ + (vvalid ? kt : 0)) * ZP + 384 + kvh * 64 + 32 * vdh);
#pragma unroll
        for (int q = 0; q < 4; ++q) vw[q] = src[q];
    }
    {
        const int kk = tid >> 1, hf = tid & 1; const int kt = blk * 128 - 128 + kk; const bool valid = kt >= 0;
        float xa[16], xb[16];
        { const bf16* src = Z + (size_t)(b * SEQ + (valid ? kt : 0)) * ZP + 256 + kvh * 64 + 16 * hf;
            const v4u w0 = *(const v4u*)src, w1 = *(const v4u*)(src + 8), w2 = *(const v4u*)(src + 32), w3 = *(const v4u*)(src + 40);
            UNPACK8(w0, xa, 0); UNPACK8(w1, xa, 8); UNPACK8(w2, xb, 0); UNPACK8(w3, xb, 8); }
        if (!valid) {
#pragma unroll
            for (int j = 0; j < 16; ++j) { xa[j] = 0.f; xb[j] = 0.f; } }
        float ss = 0.f;
#pragma unroll
        for (int j = 0; j < 16; ++j) ss += xa[j] * xa[j] + xb[j] * xb[j];
        ss += __shfl_xor(ss, 1);
        const float rs = rsqrtf(ss * (1.f / 64.f) + EPS);
        const int kp = valid ? kt : 0;
#pragma unroll
        for (int j = 0; j < 16; ++j) {
            const float c = cosT[kp * 32 + 16 * hf + j], sn = sinT[kp * 32 + 16 * hf + j];
            const float x1 = xa[j] * rs * kgain[16 * hf + j], x2 = xb[j] * rs * kgain[32 + 16 * hf + j];
            xa[j] = x1 * c - x2 * sn; xb[j] = x2 * c + x1 * sn;
        }
        v4u w;
        w.x = pk2(xa[0], xa[1]); w.y = pk2(xa[2], xa[3]); w.z = pk2(xa[4], xa[5]); w.w = pk2(xa[6], xa[7]); *(LAS v4u*)(Kl + kk * 72 + 16 * hf) = w;
        w.x = pk2(xa[8], xa[9]); w.y = pk2(xa[10], xa[11]); w.z = pk2(xa[12], xa[13]); w.w = pk2(xa[14], xa[15]); *(LAS v4u*)(Kl + kk * 72 + 16 * hf + 8) = w;
        w.x = pk2(xb[0], xb[1]); w.y = pk2(xb[2], xb[3]); w.z = pk2(xb[4], xb[5]); w.w = pk2(xb[6], xb[7]); *(LAS v4u*)(Kl + kk * 72 + 32 + 16 * hf) = w;
        w.x = pk2(xb[8], xb[9]); w.y = pk2(xb[10], xb[11]); w.z = pk2(xb[12], xb[13]); w.w = pk2(xb[14], xb[15]); *(LAS v4u*)(Kl + kk * 72 + 32 + 16 * hf + 8) = w;
    }
    {
        const int kk = vkk, dh = vdh;
        v4u w[4];
#pragma unroll
        for (int q = 0; q < 4; ++q) w[q] = vvalid ? vw[q] : (v4u){0u, 0u, 0u, 0u};
        LAS bf16* vt = Vt + (32 * dh) * 280 + kk;
#pragma unroll
        for (int q = 0; q < 4; ++q) {
            vt[(8 * q + 0) * 280] = (bf16)(w[q][0] & 0xffffu); vt[(8 * q + 1) * 280] = (bf16)(w[q][0] >> 16);
            vt[(8 * q + 2) * 280] = (bf16)(w[q][1] & 0xffffu); vt[(8 * q + 3) * 280] = (bf16)(w[q][1] >> 16);
            vt[(8 * q + 4) * 280] = (bf16)(w[q][2] & 0xffffu); vt[(8 * q + 5) * 280] = (bf16)(w[q][2] >> 16);
            vt[(8 * q + 6) * 280] = (bf16)(w[q][3] & 0xffffu); vt[(8 * q + 7) * 280] = (bf16)(w[q][3] >> 16);
        }
        if (kk < 24) {
#pragma unroll 8
            for (int d = 0; d < 32; ++d) Vt[(32 * dh + d) * 280 + 256 + kk] = (bf16)0;
        }
    }
    __syncthreads();
    const int ql = lane & 15, g = lane >> 4;
#pragma unroll
    for (int rr = 0; rr < 2; ++rr) {
        const int task = wave + 8 * rr, hl = task >> 3, qt = task & 7, h = kvh * 2 + hl;
        const int tq = blk * 128 + qt * 16 + ql; const size_t tok = (size_t)b * SEQ + tq;
        bf16x8 Qb0, Qb1;
        {
            const v4u w1 = *(const v4u*)(Z + tok * ZP + h * 64 + 8 * g), w2 = *(const v4u*)(Z + tok * ZP + h * 64 + 32 + 8 * g);
            float x1[8], x2[8]; UNPACK8(w1, x1, 0); UNPACK8(w2, x2, 0);
            float ss = 0.f;
#pragma unroll
            for (int j = 0; j < 8; ++j) ss += x1[j] * x1[j] + x2[j] * x2[j];
            ss += __shfl_xor(ss, 16); ss += __shfl_xor(ss, 32);
            const float rs = rsqrtf(ss * (1.f / 64.f) + EPS) * 0.125f;
            float o1[8], o2[8];
#pragma unroll
            for (int j = 0; j < 8; ++j) {
                const float c = cosT[tq * 32 + 8 * g + j], s = sinT[tq * 32 + 8 * g + j];
                const float y1 = x1[j] * rs * qgain[8 * g + j], y2 = x2[j] * rs * qgain[32 + 8 * g + j];
                o1[j] = y1 * c - y2 * s; o2[j] = y2 * c + y1 * s;
            }
            Qb0 = pack8((f32x4){o1[0], o1[1], o1[2], o1[3]}, (f32x4){o1[4], o1[5], o1[6], o1[7]});
            Qb1 = pack8((f32x4){o2[0], o2[1], o2[2], o2[3]}, (f32x4){o2[4], o2[5], o2[6], o2[7]});
        }
        f32x4 sc[9];
#pragma unroll
        for (int t = 0; t < 9; ++t) {
            const LAS bf16* kp = Kl + (16 * (qt + t) + ql) * 72 + 8 * g;
            f32x4 acc = (f32x4){0.f, 0.f, 0.f, 0.f};
            acc = __builtin_amdgcn_mfma_f32_16x16x32_bf16(*(const LAS bf16x8*)kp, Qb0, acc, 0, 0, 0);
            acc = __builtin_amdgcn_mfma_f32_16x16x32_bf16(*(const LAS bf16x8*)(kp + 32), Qb1, acc, 0, 0, 0);
            sc[t] = acc;
        }
        float mx = -INFINITY;
#pragma unroll
        for (int t = 0; t < 9; ++t)
#pragma unroll
            for (int e = 0; e < 4; ++e) {
                const int rel = 128 + ql - 16 * t - 4 * g - e, kj = 16 * (qt + t) + 4 * g + e;
                const bool ok = (rel >= 0) && (rel < 128) && (blk > 0 || kj >= 128);
                const float v = ok ? sc[t][e] : -INFINITY; sc[t][e] = v; mx = fmaxf(mx, v);
            }
        mx = fmaxf(mx, __shfl_xor(mx, 16)); mx = fmaxf(mx, __shfl_xor(mx, 32));
        const float sk = sink[h]; const float mm = fmaxf(mx, sk);
        float sum = 0.f;
#pragma unroll
        for (int t = 0; t < 9; ++t)
#pragma unroll
            for (int e = 0; e < 4; ++e) { const float ev = __expf(sc[t][e] - mm); sc[t][e] = ev; sum += ev; }
        sum += __shfl_xor(sum, 16); sum += __shfl_xor(sum, 32);
        const float inv = 1.f / (sum + __expf(sk - mm));
        f32x4 o[4];
#pragma unroll
        for (int dt = 0; dt < 4; ++dt) o[dt] = (f32x4){0.f, 0.f, 0.f, 0.f};
#pragma unroll
        for (int ks = 0; ks < 5; ++ks) {
            const f32x4 plo = sc[2 * ks] * inv;
            const f32x4 phi = (2 * ks + 1 < 9) ? sc[(2 * ks + 1 < 9) ? 2 * ks + 1 : 8] * inv : (f32x4){0.f, 0.f, 0.f, 0.f};
            const bf16x8 Pb = pack8(plo, phi);
#pragma unroll
            for (int dt = 0; dt < 4; ++dt) {
                const LAS bf16* vp = Vt + (16 * dt + ql) * 280 + 16 * (qt + 2 * ks) + 4 * g;
                const v2u lo = *(const LAS v2u*)vp, hi = *(const LAS v2u*)(vp + 16);
                const v4u av = (v4u){lo.x, lo.y, hi.x, hi.y};
                o[dt] = __builtin_amdgcn_mfma_f32_16x16x32_bf16(__builtin_bit_cast(bf16x8, av), Pb, o[dt], 0, 0, 0);
            }
        }
#pragma unroll
        for (int dt = 0; dt < 4; ++dt) {
            const int col = h * 64 + 16 * dt + 4 * g;
            const v2u gw = *(const v2u*)(Z + tok * ZP + ZC_GATE + col);
            v2u w; w.x = pk2(o[dt][0] * siluf_(bflo(gw.x)), o[dt][1] * siluf_(bfhi(gw.x))); w.y = pk2(o[dt][2] * siluf_(bflo(gw.y)), o[dt][3] * siluf_(bfhi(gw.y)));
            *(v2u*)(MIX + tok * DM + col) = w;
        }
    }
    __syncthreads();
}

__device__ __forceinline__ void mixer_c(const Args& a, int layer, int item, lds_t lds) {
    const int tid = opaque_tid(), lane = tid & 63, wave = tid >> 6;
    const int b = item >> 6, cn = item & 63; const size_t tok0 = (size_t)b * SEQ + cn * 128;
    unsigned char* ws = a.ws;
    const bf16* Z = (const bf16*)(ws + WS_Z);
    bf16* MIX = (bf16*)(ws + WS_XB);
    const bf16* CWS = (const bf16*)(ws + WS_CWS);
    LAS bf16* Vt = (LAS bf16*)lds;
    {
        const int t = tid >> 2, q = tid & 3; const size_t tok = tok0 + t;
        const v4u* src = (const v4u*)(Z + tok * ZP + 1536 + 64 * q);
        float x[64];
#pragma unroll
        for (int k = 0; k < 8; ++k) { const v4u w = src[k]; UNPACK8(w, x, 8 * k); }
        float s = 0.f;
#pragma unroll
        for (int j = 0; j < 64; ++j) { x[j] = geluf_(x[j]); s += x[j]; }
        s = quad_sum(s); const float mean = s * (1.f / 256.f);
        float s2 = 0.f;
#pragma unroll
        for (int j = 0; j < 64; ++j) { x[j] -= mean; s2 += x[j] * x[j]; }
        s2 = quad_sum(s2); const float rstd = rsqrtf(s2 * (1.f / 256.f) + EPS);
        const float* gn = a.in[12] + layer * 256 + 64 * q; const float* bs = a.in[13] + layer * 256 + 64 * q;
#pragma unroll
        for (int j = 0; j < 64; ++j) Vt[(64 * q + j) * 136 + t] = (bf16)f2bf(x[j] * rstd * gn[j] + bs[j]);
    }
    __syncthreads();
    {
        const int gq = wave >> 1, par = wave & 1, ql = lane & 15, g = lane >> 4;
#pragma unroll
        for (int ii = 0; ii < 4; ++ii) {
            const int it = par + 2 * ii, nks = (it >> 1) + 1;
            f32x4 acc[4];
#pragma unroll
            for (int ct = 0; ct < 4; ++ct) acc[ct] = (f32x4){0.f, 0.f, 0.f, 0.f};
            for (int ks = 0; ks < nks; ++ks) {
                const bf16x8 Bv = *(const bf16x8*)(CWS + ((size_t)((layer * 4 + gq) * 128 + 16 * it + ql)) * 128 + 32 * ks + 8 * g);
#pragma unroll
                for (int ct = 0; ct < 4; ++ct) {
                    const bf16x8 Av = *(const LAS bf16x8*)(Vt + (gq * 64 + 16 * ct + ql) * 136 + 32 * ks + 8 * g);
                    acc[ct] = __builtin_amdgcn_mfma_f32_16x16x32_bf16(Av, Bv, acc[ct], 0, 0, 0);
                }
            }
            const int ti = 16 * it + ql; const size_t tok = tok0 + ti;
            const float bsv = a.in[15][(layer * 4 + gq) * 128 + ti];
#pragma unroll
            for (int ct = 0; ct < 4; ++ct) {
                const int c = gq * 64 + 16 * ct + 4 * g;
                const v2u uw = *(const v2u*)(Z + tok * ZP + 1280 + c), gw = *(const v2u*)(Z + tok * ZP + ZC_GATE + 512 + c);
                v2u w;
                w.x = pk2(geluf_(bflo(uw.x)) * (acc[ct][0] + bsv) * siluf_(bflo(gw.x)), geluf_(bfhi(uw.x)) * (acc[ct][1] + bsv) * siluf_(bfhi(gw.x)));
                w.y = pk2(geluf_(bflo(uw.y)) * (acc[ct][2] + bsv) * siluf_(bflo(gw.y)), geluf_(bfhi(uw.y)) * (acc[ct][3] + bsv) * siluf_(bfhi(gw.y)));
                *(v2u*)(MIX + tok * DM + 512 + c) = w;
            }
        }
    }
    __syncthreads();
}

__device__ __forceinline__ void mixer_d(const Args& a, int layer, int item, lds_t lds) {
    const int tid = opaque_tid(), lane = tid & 63, wave = tid >> 6;
    const int ch = item & 1, tn = (item >> 1) & 63, b = item >> 7; const int t0s = tn * 128;
    unsigned char* ws = a.ws;
    const bf16* Z = (const bf16*)(ws + WS_Z);
    bf16* MIX = (bf16*)(ws + WS_XB);
    LAS float* Y = (LAS float*)lds;
    {
        v4u aw[5], gw[5]; int rowv[5], cgv[5]; float okv[5];
#pragma unroll
        for (int it5 = 0; it5 < 5; ++it5) {
            const int task = tid + 512 * it5; const bool tv = task < 158 * 16; const int tk = tv ? task : 0;
            const int row = tk >> 4, cg = tk & 15; const int sp = t0s - 30 + row; const bool okb = tv && sp >= 0;
            const size_t tok = (size_t)b * SEQ + (okb ? sp : 0);
            aw[it5] = *(const v4u*)(Z + tok * ZP + 1792 + ch * 128 + cg * 8); gw[it5] = *(const v4u*)(Z + tok * ZP + 2048 + ch * 128 + cg * 8);
            rowv[it5] = tv ? row : -1; cgv[it5] = cg; okv[it5] = okb ? 1.f : 0.f;
        }
#pragma unroll
        for (int it5 = 0; it5 < 5; ++it5) {
            float av[8], gv[8]; UNPACK8(aw[it5], av, 0); UNPACK8(gw[it5], gv, 0);
            const float k = okv[it5];
            const f32x4 y0 = (f32x4){k * av[0] * sigmoidf_(gv[0]), k * av[1] * sigmoidf_(gv[1]), k * av[2] * sigmoidf_(gv[2]), k * av[3] * sigmoidf_(gv[3])};
            const f32x4 y1 = (f32x4){k * av[4] * sigmoidf_(gv[4]), k * av[5] * sigmoidf_(gv[5]), k * av[6] * sigmoidf_(gv[6]), k * av[7] * sigmoidf_(gv[7])};
            if (rowv[it5] >= 0) { *(LAS f32x4*)(Y + rowv[it5] * 128 + cgv[it5] * 8) = y0; *(LAS f32x4*)(Y + rowv[it5] * 128 + cgv[it5] * 8 + 4) = y1; }
        }
    }
    __syncthreads();
    {
        const int gl = wave & 1, tq = wave >> 1, cl = gl * 64 + lane, c = ch * 128 + cl;
        float w[31];
#pragma unroll
        for (int k = 0; k < 31; ++k) w[k] = a.in[16][((size_t)layer * 31 + k) * 256 + c];
        const float bias = a.in[17][layer * 256 + c], lng = a.in[18][layer * 256 + c], lnb = a.in[19][layer * 256 + c];
#pragma unroll 1
        for (int run = 0; run < 4; ++run) {
            const int tb = tq * 32 + run * 8;
            float acc[8];
#pragma unroll
            for (int o = 0; o < 8; ++o) acc[o] = bias;
#pragma unroll
            for (int r = 0; r < 38; ++r) {
                const float yv = Y[(tb + r) * 128 + cl];
#pragma unroll
                for (int o = 0; o < 8; ++o) { if (r - o >= 0 && r - o <= 30) acc[o] += w[(r - o >= 0 && r - o <= 30) ? r - o : 0] * yv; }
            }
#pragma unroll
            for (int o = 0; o < 8; ++o) {
                const float mean = wave_sum_dpp(acc[o]) * (1.f / 64.f);
                const float d = acc[o] - mean;
                const float var = wave_sum_dpp(d * d) * (1.f / 64.f);
                float y = d * rsqrtf(var + EPS) * lng + lnb;
                y = siluf_(y);
                const size_t tok = (size_t)b * SEQ + t0s + tb + o;
                const float gt = bflo((unsigned)Z[tok * ZP + ZC_GATE + 768 + c]);
                MIX[tok * DM + 768 + c] = (bf16)f2bf(y * siluf_(gt));
            }
        }
    }
    __syncthreads();
}

__device__ __forceinline__ void finalize_b(const Args& a, int layer) {
    unsigned char* ws = a.ws;
    const bf16* Z = (const bf16*)(ws + WS_Z);
    bf16* MIX = (bf16*)(ws + WS_XB);
    const int gt = blockIdx.x * 512 + opaque_tid(), NT = gridDim.x * 512;
    for (int task = gt; task < M * 16; task += NT) {
        const int q = task & 3, hh = (task >> 2) & 3; const size_t tok = (size_t)(task >> 4);
        const f32x4* ob = (const f32x4*)((const float*)((const unsigned char*)Z + tok * (size_t)(ZP * 2) + 1024) + hh * 64 + q * 16);
        f32x4 v[4]; float ss = 0.f;
#pragma unroll
        for (int k = 0; k < 4; ++k) { v[k] = ob[k]; ss += (v[k][0] * v[k][0] + v[k][1] * v[k][1]) + (v[k][2] * v[k][2] + v[k][3] * v[k][3]); }
        ss = quad_sum(ss);
        const float rs = rsqrtf(ss * (1.f / 64.f) + EPS);
        const int col = 256 + hh * 64 + q * 16;
        const v4u g0 = *(const v4u*)(Z + tok * ZP + ZC_GATE + col), g1 = *(const v4u*)(Z + tok * ZP + ZC_GATE + col + 8);
        float gv[16]; UNPACK8(g0, gv, 0); UNPACK8(g1, gv, 8);
        const float* gn = a.in[11] + layer * 64 + q * 16;
        float o[16];
#pragma unroll
        for (int k = 0; k < 4; ++k)
#pragma unroll
            for (int e = 0; e < 4; ++e) o[4 * k + e] = v[k][e] * rs * gn[4 * k + e] * siluf_(gv[4 * k + e]);
        v4u w0, w1;
        w0.x = pk2(o[0], o[1]); w0.y = pk2(o[2], o[3]); w0.z = pk2(o[4], o[5]); w0.w = pk2(o[6], o[7]);
        w1.x = pk2(o[8], o[9]); w1.y = pk2(o[10], o[11]); w1.z = pk2(o[12], o[13]); w1.w = pk2(o[14], o[15]);
        *(v4u*)(MIX + tok * DM + col) = w0; *(v4u*)(MIX + tok * DM + col + 8) = w1;
    }
}

__device__ __forceinline__ void convert_p(const Args& a, int L) {
    const f32x4* src = (const f32x4*)(a.in[1] + (size_t)L * M * 256);
    v4u* dst = (v4u*)(a.ws + WS_DN);
    const int gt = blockIdx.x * 512 + opaque_tid(), NT = gridDim.x * 512;
    for (int t = gt; t < M * 256 / 8; t += NT) { const f32x4 v0 = src[2 * t], v1 = src[2 * t + 1];
        v4u w; w.x = pk2(v0[0], v0[1]); w.y = pk2(v0[2], v0[3]); w.z = pk2(v1[0], v1[1]); w.w = pk2(v1[2], v1[3]); dst[t] = w; }
}
#define XB_TMO      128
#define XB_XCNT(j)  (256  + 64 * (j))
#define XB_XSUB(j)  (1280 + 64 * (j))
#define XB_XGEN(j)  (2304 + 64 * (j))
#define XB_TOP      3328
#define XB_TOPGEN   3392
#define XCD_BAR_WORDS 3456
#define XB_SPIN_CAP (1u << 18)

__device__ __forceinline__ unsigned xb_ld(unsigned* p)              { return __hip_atomic_load(p, __ATOMIC_RELAXED, __HIP_MEMORY_SCOPE_AGENT); }
__device__ __forceinline__ unsigned xb_add(unsigned* p, unsigned v) { return __hip_atomic_fetch_add(p, v, __ATOMIC_RELAXED, __HIP_MEMORY_SCOPE_AGENT); }
__device__ __forceinline__ unsigned xb_xcc_id() { return (unsigned)__builtin_amdgcn_s_getreg((3 << 11) | 20) & 0xFu; }
#define XB_SPIN(cond, bar) do { unsigned _sp = 0; while (cond) { __builtin_amdgcn_s_sleep(1); \
    if ((++_sp & 255u) == 0u) { if (xb_ld(&(bar)[XB_TMO])) break; if (_sp > XB_SPIN_CAP) { atomicAdd(&(bar)[XB_TMO], 1u); break; } } } } while (0)

struct XcdBarrier {
    unsigned* bar; unsigned x;
    volatile LAS unsigned* st;
};

__device__ __forceinline__ XcdBarrier xcd_barrier_post(unsigned* bar, volatile LAS unsigned* st) {
    XcdBarrier b; b.bar = bar; b.x = xb_xcc_id(); b.st = st;
    if (threadIdx.x == 0) (void)xb_add(&bar[XB_XCNT(b.x)], 1u);
    return b;
}
__device__ __forceinline__ void xcd_barrier_complete(unsigned* bar, unsigned x, unsigned& nloc, unsigned& nx) {
    const unsigned G = gridDim.x * gridDim.y * gridDim.z;
    unsigned sum, cnt, mine, sp = 0u;
    for (;;) {
        sum = 0u; cnt = 0u; mine = 0u;
#pragma unroll
        for (unsigned j = 0; j < 16; ++j) { const unsigned c = xb_ld(&bar[XB_XCNT(j)]); sum += c; cnt += (c > 0u) ? 1u : 0u; mine = (j == x) ? c : mine; }
        if (sum == G) break;
        __builtin_amdgcn_s_sleep(1);
        if ((++sp & 255u) == 0u) { if (xb_ld(&bar[XB_TMO])) break; if (sp > XB_SPIN_CAP) { atomicAdd(&bar[XB_TMO], 1u); break; } }
    }
    nloc = mine > 0u ? mine : 1u; nx = cnt > 0u ? cnt : 1u;
}

__device__ __forceinline__ void xcd_barrier(const XcdBarrier& b) {
    asm volatile("s_waitcnt vmcnt(0)" ::: "memory");
    __syncthreads();
    if (threadIdx.x == 0) {
        unsigned* bar = b.bar;
        __builtin_amdgcn_s_waitcnt(0);
        unsigned nloc = b.st[0], nx = b.st[1];
        if (nloc == 0u) { xcd_barrier_complete(bar, b.x, nloc, nx); b.st[0] = nloc; b.st[1] = nx; }
        const unsigned old = xb_add(&bar[XB_XSUB(b.x)], 1u);
        const unsigned gen = old / nloc;
        if (old + 1u == (gen + 1u) * nloc) {
            __builtin_amdgcn_fence(__ATOMIC_RELEASE, "agent");
            asm volatile("s_waitcnt vmcnt(0)" ::: "memory");
            const unsigned og = xb_add(&bar[XB_TOP], 1u);
            const unsigned tg = og / nx;
            if (og + 1u == (tg + 1u) * nx) xb_add(&bar[XB_TOPGEN], 1u);
            else XB_SPIN(xb_ld(&bar[XB_TOPGEN]) == tg, bar);
            __builtin_amdgcn_fence(__ATOMIC_ACQUIRE, "agent");
            xb_add(&bar[XB_XGEN(b.x)], 1u);
            asm volatile("s_waitcnt vmcnt(0)" ::: "memory");
        } else {
            XB_SPIN(xb_ld(&bar[XB_XGEN(b.x)]) == gen, bar);
            __builtin_amdgcn_fence(__ATOMIC_ACQUIRE, "agent");
            asm volatile("s_waitcnt vmcnt(0)" ::: "memory");
        }
    }
    __syncthreads();
}

__device__ __forceinline__ void flat_barrier(unsigned* cnt, unsigned& epoch) {
    asm volatile("s_waitcnt vmcnt(0)" ::: "memory");
    __syncthreads();
    epoch += gridDim.x;
    if (threadIdx.x == 0) {
        __builtin_amdgcn_fence(__ATOMIC_RELEASE, "agent");
        asm volatile("s_waitcnt vmcnt(0)" ::: "memory");
        __hip_atomic_fetch_add(cnt, 1u, __ATOMIC_RELAXED, __HIP_MEMORY_SCOPE_AGENT);
        unsigned sp = 0;
        while (__hip_atomic_load(cnt, __ATOMIC_RELAXED, __HIP_MEMORY_SCOPE_AGENT) < epoch) { __builtin_amdgcn_s_sleep(1); if (++sp > (1u << 22)) break; }
        __builtin_amdgcn_fence(__ATOMIC_ACQUIRE, "agent");
        asm volatile("s_waitcnt vmcnt(0)" ::: "memory");
    }
    __syncthreads();
}
constexpr int NPH = 13;
__global__ void __launch_bounds__(512, 2) mega_fwd(Args a) {
    extern __shared__ __attribute__((aligned(16))) unsigned char smem[];
    lds_t lds = (lds_t)smem;
    cg::grid_group grid = cg::this_grid();
    const int tid = opaque_tid(), G = gridDim.x, bid = blockIdx.x;
    unsigned char* ws = a.ws;
    unsigned* ctl = (unsigned*)(ws + WS_CTL);
    const int lo = a.ph_lo, hi = a.ph_hi;
    volatile LAS unsigned* bst = (volatile LAS unsigned*)(lds + MISC_OFF + 64);
    if (tid < 2) bst[tid] = 0u;
    __syncthreads();
    const XcdBarrier xbar = xcd_barrier_post(ctl + CW_BAR, bst);
#define IN(k) (lo <= (k) && (k) < hi)
    unsigned fepoch = 0;
#define GBAR() do { if (BARRIER_KIND == 0) grid.sync(); else if (BARRIER_KIND == 1) flat_barrier(ctl + CW_BAR + 4096, fepoch); else xcd_barrier(xbar); } while (0)
#define SEAM(k) do { if (IN(k) && IN((k) + 1)) { if ((CG_SEAM_MASK >> (k)) & 1u) grid.sync(); else GBAR(); } } while (0)

    if (lo < 0) grid.sync();
    if (IN(0)) for (int rep = 0; rep < PROBE_REP_P0; ++rep) { p0_prologue(a, lds); convert_p(a, 0); }
    SEAM(0);
#pragma unroll 1
    for (int L = 0; L < 2; ++L) {
        const int pb = 1 + 6 * L;
        float* ssin = L == 0 ? (float*)ctl + CW_SS0 : (float*)(ws + WS_SSP + 2 * MiB);
        float* ss1 = (float*)(ws + WS_SSP + (size_t)L * MiB);
        if (IN(pb)) for (int rep = 0; rep < PROBE_REP_G1; ++rep) {
            {
                pg8::Gemm g{(const bf16*)(ws + WS_XB), (const bf16*)(ws + WS_WIN) + (size_t)L * ZP * DM, M, ZP, DM};
                pg8::StaticOrder S; S.init(M, ZP, G, bid);
                EpiZ E{(bf16*)(ws + WS_Z), ssin, (float*)(ws + WS_BA), L == 0 ? 1 : 16};
                pg8::gemm_phase<EpiZ, pg8::StaticOrder, true, true>(lds, g, S, E);
            }
            {
                pg8::Gemm g2{(const bf16*)(ws + WS_DN), (const bf16*)(ws + WS_WPLE) + (size_t)L * DM * 256, M, DM, 256};
                pg8::StaticOrder S2;
                if (G == 256) S2.init(M, DM, 128, bid >= 128 ? bid - 128 : (1 << 20)); else S2.init(M, DM, G, bid);
                EpiPlain E2{(bf16*)(ws + WS_PP), DM};
                pg8::gemm_phase<EpiPlain, pg8::StaticOrder, true, true>(lds, g2, S2, E2);
            }
        }
        SEAM(pb);
        if (IN(pb + 1)) {
            for (int rep = 0; rep < PROBE_REP_PREP; ++rep) for (int it = bid; it < 1024; it += G) dn_prep(a, L, it, lds);
        }
        SEAM(pb + 1);
        if (IN(pb + 2)) for (int rep = 0; rep < PROBE_REP_M2; ++rep) {
            if (rep) GBAR();
            if (bid < 32 && !(rep && PROBE_M2_MODE == 2)) dn_scan(a, bid & 7, bid >> 3, lds);
            if (rep && PROBE_M2_MODE == 1) continue;
            volatile LAS int* misc = (volatile LAS int*)(lds + MISC_OFF);
            __syncthreads();
            if (tid == 0) misc[0] = (int)atomicAdd(ctl + CW_CTR + 16 * L + 4 * rep, 1u);
            __syncthreads();
            for (;;) {
                const int it = misc[0];
                if (it >= 640) break;
                unsigned nxt_item = 0u;
                if (tid == 0) nxt_item = atomicAdd(ctl + CW_CTR + 16 * L + 4 * rep, 1u);
                if (it < 256) { if (!rep || (PROBE_MIX_MASK & 4)) mixer_d(a, L, it, lds); }
                else if (it < 384) { if (!rep || (PROBE_MIX_MASK & 1)) mixer_c(a, L, it - 256, lds); }
                else { if (!rep || (PROBE_MIX_MASK & 2)) mixer_a(a, L, it - 384, lds); }
                __syncthreads();
                if (tid == 0) misc[0] = (int)nxt_item;
                __syncthreads();
            }
        }
        SEAM(pb + 2);
        for (int xs = 0; xs < PROBE_EXTRA_SYNC; ++xs) GBAR();
        if (IN(pb + 3)) for (int rep = 0; rep < PROBE_REP_FIN; ++rep) { finalize_b(a, L); if (L == 0) convert_p(a, 1); }
        SEAM(pb + 3);
        if (IN(pb + 4)) for (int rep = 0; rep < PROBE_REP_G23; ++rep) {
            pg8::Gemm g{(const bf16*)(ws + WS_XB), (const bf16*)(ws + WS_WOUT) + (size_t)L * DM * DM, M, DM, DM};
            pg8::StaticOrder S; S.init(M, DM, G, bid);
            EpiRes E{L == 0 ? a.in[0] : a.out, (bf16*)(ws + WS_X1B), ss1};
            pg8::gemm_phase<EpiRes, pg8::StaticOrder, true, true>(lds, g, S, E);
        }
        SEAM(pb + 4);
        if (IN(pb + 5)) for (int rep = 0; rep < PROBE_REP_G23; ++rep) {
            pg8::Gemm g{(const bf16*)(ws + WS_X1B), (const bf16*)(ws + WS_WG) + (size_t)L * DM * DM, M, DM, DM};
            pg8::StaticOrder S; S.init(M, DM, G, bid);
            EpiOut E{(const bf16*)(ws + WS_X1B), ss1, (const bf16*)(ws + WS_PP), a.out, (bf16*)(ws + WS_XB), (float*)(ws + WS_SSP + 2 * MiB), L == 1 ? 1 : 0};
            pg8::gemm_phase<EpiOut, pg8::StaticOrder, true, true>(lds, g, S, E);
        }
        if (L == 0) SEAM(pb + 5);
    }
#undef IN
#undef SEAM
}

extern "C" void kernel_launch(void* const* d_in, const int* in_sizes, int n_in, void* d_out, int out_size, void* d_ws, size_t ws_size, hipStream_t stream) {
    static int grid = 0;
    if (grid == 0) {
        if (n_in != 23 || ws_size < WS_END) { fprintf(stderr, "kernel_launch: unexpected inputs (n_in %d, ws %zu)\n", n_in, ws_size); grid = -1; return; }
        int dev = 0, cus = 0, per_cu = 0;
        hipGetDevice(&dev);
        hipDeviceGetAttribute(&cus, hipDeviceAttributeMultiprocessorCount, dev);
        hipFuncSetAttribute((const void*)mega_fwd, hipFuncAttributeMaxDynamicSharedMemorySize, LDS_BYTES);
        hipOccupancyMaxActiveBlocksPerMultiprocessor(&per_cu, (const void*)mega_fwd, 512, LDS_BYTES);
        if (per_cu < 1) { fprintf(stderr, "kernel_launch: occupancy query says %d blocks per CU\n", per_cu); per_cu = 1; }
        (void)hipGetLastError();
        grid = cus;
        if (grid > 256) grid = 256;
    }
    if (grid < 0) return;
    hipMemsetAsync((char*)d_ws + WS_CTL, 0, CTL_BYTES, stream);
    Args a{};
    for (int i = 0; i < 23; ++i) a.in[i] = (const float*)d_in[i];
    a.out = (float*)d_out; a.ws = (unsigned char*)d_ws; a.ph_lo = 0; a.ph_hi = NPH;
    void* kargs[] = {&a};
    hipError_t e = hipLaunchCooperativeKernel((const void*)mega_fwd, dim3(grid), dim3(512), kargs, LDS_BYTES, stream);
    if (e != hipSuccess) fprintf(stderr, "cooperative launch failed: %s (grid %d)\n", hipGetErrorString(e), grid);
}
```
